# Optimizing an MI355X kernel written in HIP

```python
import math
import jax, jax.numpy as jnp
from jax import lax
import numpy as np

D_MODEL = 1024
BATCH = 8
SEQ = 4096
DEPTH = 2

N_MIXERS = 2
N_CONV_LAYERS = (DEPTH + 1) // 2
N_ATTN_LAYERS = DEPTH // 2
D_FF = 2816
CONV_WIDTH = 31
N_HEADS = 16
HEAD_DIM = D_MODEL // N_HEADS
D_ATTN = N_HEADS * HEAD_DIM
BLOCK_Q = 128
RMS_EPS = 1e-6
LN_EPS = 1e-5

kernel_name = "macaron_conv_stickbreaking_hybrid"


def rms_norm(x, g):
    xf = x.astype(jnp.float32)
    y = xf * lax.rsqrt(jnp.mean(xf * xf, axis=-1, keepdims=True) + RMS_EPS)
    return (y * g.astype(jnp.float32)).astype(x.dtype)


def layer_norm(x, g, b):
    xf = x.astype(jnp.float32)
    mu = jnp.mean(xf, axis=-1, keepdims=True)
    var = jnp.mean(jnp.square(xf - mu), axis=-1, keepdims=True)
    y = (xf - mu) * lax.rsqrt(var + LN_EPS)
    return (y * g.astype(jnp.float32) + b.astype(jnp.float32)).astype(x.dtype)


def swiglu_ffn(h, w_in, w_out):
    gate, up = jnp.split(h @ w_in, 2, axis=-1)
    return (jax.nn.silu(gate) * up) @ w_out


def conformer_conv(h, w_pw1, b_pw1, w_dw, b_dw, ln_g, ln_b, w_pw2, b_pw2):
    val, gate = jnp.split(h @ w_pw1 + b_pw1, 2, axis=-1)
    u = val * jax.nn.sigmoid(gate)
    u = lax.conv_general_dilated(
        u, w_dw[:, None, :].astype(u.dtype),
        window_strides=(1,),
        padding=((CONV_WIDTH - 1, 0),),
        dimension_numbers=("NWC", "WIO", "NWC"),
        feature_group_count=D_MODEL,
    ) + b_dw
    u = jax.nn.silu(layer_norm(u, ln_g, ln_b))
    return u @ w_pw2 + b_pw2


def stick_breaking_attention(h, w_qkv, w_o):
    b, s, _ = h.shape
    qkv = (h @ w_qkv).reshape(b, s, 3, N_HEADS, HEAD_DIM)
    qkv = jnp.transpose(qkv, (2, 0, 3, 1, 4))
    q, k, v = qkv[0], qkv[1], qkv[2]
    n_blk = s // BLOCK_Q
    q_blocks = jnp.transpose(q.reshape(b, N_HEADS, n_blk, BLOCK_Q, HEAD_DIM), (2, 0, 1, 3, 4))
    starts = jnp.arange(n_blk, dtype=jnp.int32) * BLOCK_Q
    key_pos = jnp.arange(s, dtype=jnp.int32)
    scale = 1.0 / math.sqrt(HEAD_DIM)

    def one_block(args):
        qb, start = args
        z = jnp.einsum("bhqd,bhkd->bhqk", qb, k).astype(jnp.float32) * scale
        q_pos = start + jnp.arange(BLOCK_Q, dtype=jnp.int32)
        mask = key_pos[None, :] < q_pos[:, None]
        log_beta = jax.nn.log_sigmoid(z)
        log_1m = jnp.where(mask, log_beta - z, 0.0)
        suffix = lax.cumsum(log_1m, axis=3, reverse=True) - log_1m
        a = jnp.where(mask, jnp.exp(log_beta + suffix), 0.0)
        return jnp.einsum("bhqk,bhkd->bhqd", a.astype(v.dtype), v)

    out = lax.map(one_block, (q_blocks, starts))
    out = jnp.transpose(out, (1, 0, 3, 2, 4)).reshape(b, s, D_ATTN)
    return out @ w_o


def setup_inputs(seed: int = 0) -> dict:
    key = jax.random.key(seed)
    ks = jax.random.split(key, 16)
    f32 = jnp.float32
    nrm = lambda k, shape, scale: jax.random.normal(k, shape, f32) * scale
    return {
        "x": jax.random.normal(ks[0], (BATCH, SEQ, D_MODEL), f32),
        "norm_g": 1.0 + nrm(ks[1], (DEPTH, 3, D_MODEL), 0.01),
        "final_g": 1.0 + nrm(ks[2], (D_MODEL,), 0.01),
        "ffn_w_in": nrm(ks[3], (DEPTH, 2, D_MODEL, 2 * D_FF), D_MODEL ** -0.5),
        "ffn_w_out": nrm(ks[4], (DEPTH, 2, D_FF, D_MODEL), D_FF ** -0.5),
        "conv_w_pw1": nrm(ks[5], (N_CONV_LAYERS, D_MODEL, 2 * D_MODEL), D_MODEL ** -0.5),
        "conv_b_pw1": nrm(ks[6], (N_CONV_LAYERS, 2 * D_MODEL), 0.01),
        "conv_w_dw": nrm(ks[7], (N_CONV_LAYERS, CONV_WIDTH, D_MODEL), CONV_WIDTH ** -0.5),
        "conv_b_dw": nrm(ks[8], (N_CONV_LAYERS, D_MODEL), 0.01),
        "conv_ln_g": 1.0 + nrm(ks[9], (N_CONV_LAYERS, D_MODEL), 0.01),
        "conv_ln_b": nrm(ks[10], (N_CONV_LAYERS, D_MODEL), 0.01),
        "conv_w_pw2": nrm(ks[11], (N_CONV_LAYERS, D_MODEL, D_MODEL), D_MODEL ** -0.5),
        "conv_b_pw2": nrm(ks[12], (N_CONV_LAYERS, D_MODEL), 0.01),
        "attn_w_qkv": nrm(ks[13], (N_ATTN_LAYERS, D_MODEL, 3 * D_ATTN), D_MODEL ** -0.5),
        "attn_w_o": nrm(ks[14], (N_ATTN_LAYERS, D_ATTN, D_MODEL), D_ATTN ** -0.5),
    }


def reference(x, norm_g, final_g, ffn_w_in, ffn_w_out,
              conv_w_pw1, conv_b_pw1, conv_w_dw, conv_b_dw, conv_ln_g, conv_ln_b,
              conv_w_pw2, conv_b_pw2, attn_w_qkv, attn_w_o):
    for i in range(DEPTH):
        g = norm_g[i]
        x = x + 0.5 * swiglu_ffn(rms_norm(x, g[0]), ffn_w_in[i, 0], ffn_w_out[i, 0])
        h = rms_norm(x, g[1])
        j = i // N_MIXERS
        if i % N_MIXERS == 0:
            x = x + conformer_conv(h, conv_w_pw1[j], conv_b_pw1[j], conv_w_dw[j], conv_b_dw[j],
                                   conv_ln_g[j], conv_ln_b[j], conv_w_pw2[j], conv_b_pw2[j])
        else:
            x = x + stick_breaking_attention(h, attn_w_qkv[j], attn_w_o[j])
        x = x + 0.5 * swiglu_ffn(rms_norm(x, g[2]), ffn_w_in[i, 1], ffn_w_out[i, 1])
    return rms_norm(x, final_g)
```

```cpp
#include <hip/hip_runtime.h>
#include <hip/hip_cooperative_groups.h>
#include <cstdio>
#include <cstdint>
namespace cg = cooperative_groups;
namespace pg8 {
#define PG8_LAS __attribute__((address_space(3)))
typedef unsigned short bf16_t;
typedef short bf16x8 __attribute__((ext_vector_type(8)));
typedef float f32x4 __attribute__((ext_vector_type(4)));
typedef unsigned u32x4 __attribute__((ext_vector_type(4)));
constexpr int BM = 256, BK = 64, HALF = 128, HTB = HALF * BK * 2  , STAGE_BYTES = 8 * HTB, NXCD = 8, WGM = 8;

__host__ __device__ __forceinline__ int lds_byte(int r, int c) { const int st = (r >> 4) * 2 + (c >> 5), rr = r & 15, cc = c & 31, ob = rr * 64 + cc * 2; return st * 1024 + (ob ^ (((ob >> 9) & 1) << 5)); }
__host__ __device__ __forceinline__ void stage_rc(int b, int& R, int& C) { const int st = b / 1024, sb = b % 1024, swz = sb ^ (((sb >> 9) & 1) << 5); R = (st >> 1) * 16 + swz / 64; C = (st & 1) * 32 + (swz % 64) / 2; }
__host__ __device__ __forceinline__ int perm32(int rho) { const int n = rho >> 4, i = rho & 15; return 8 * (i >> 2) + 4 * n + (i & 3); }

struct Unit { int pm, pn; };
struct Gemm { const bf16_t* A; const bf16_t* Bt; int M, N, K; };

struct StaticOrder {
    int nM, nN, nwg, G, c;
    __host__ __device__ void init(int M, int N, int G_, int c_) { nM = M / BM; nN = N / BM; nwg = nM * nN; G = G_; c = c_; }
    __host__ __device__ bool next(int i, Unit& u) const {
        const long L = (long)i * G + c; if (L >= nwg) return false;
        int wgid = (int)L; { const int q = nwg / NXCD, r = nwg % NXCD, xcd = wgid % NXCD, off = wgid / NXCD; wgid = (xcd < r ? xcd * (q + 1) : r * (q + 1) + (xcd - r) * q) + off; }
        const int nig = WGM * nN, gid = wgid / nig, fm = gid * WGM, gsz = (nM - fm) < WGM ? (nM - fm) : WGM;
        u.pm = fm + ((wgid % nig) % gsz); u.pn = (wgid % nig) / gsz; return true;
    }
    __device__ __forceinline__ void a_ready(const Unit&) const {}
    __device__ __forceinline__ void done(const Unit&) const {}
};

__device__ __forceinline__ unsigned cvt_pk_bf16(float lo, float hi) { unsigned r; asm volatile("v_cvt_pk_bf16_f32 %0, %1, %2" : "=v"(r) : "v"(lo), "v"(hi)); return r; }
template <class Epi, class Sched, bool ALIGN_EPI = false, bool SP2 = false>
__device__ __forceinline__ void gemm_phase(PG8_LAS unsigned char* lds, const Gemm g, const Sched& S, const Epi& E) {
    int tid_ = threadIdx.x; asm volatile("" : "+v"(tid_));
    const int tid = tid_, wid = __builtin_amdgcn_readfirstlane(tid >> 6), lane = tid & 63, wr = wid >> 2, wc = wid & 3, fr = lane & 15, fq = lane >> 4;
    const int K = g.K, nt = K / BK;
    unsigned voffA[2], voffB[2];
#pragma unroll
    for (int i = 0; i < 2; ++i) { int R, C; stage_rc(tid * 16 + i * 8192, R, C); const int Rb = Epi::PERM ? ((R & ~31) + perm32(R & 31)) : R;
        voffA[i] = (unsigned)(R * K + C) * 2u; voffB[i] = (unsigned)(Rb * K + C) * 2u; }
    const size_t kstep = (size_t)(BK * 2);
    const size_t hstep = (size_t)HALF * K * 2;
    const size_t tstep = 2 * hstep;
    const unsigned ldsw = (unsigned)wid * 1024u;
    const int aoff = lds_byte(wr * 64 + fr, fq * 8), boff = lds_byte(wc * 32 + fr, fq * 8);
#define PG8_SA(b, h) (((b) * 2 + (h)) * HTB)
#define PG8_SB(b, h) ((4 + (b) * 2 + (h)) * HTB)
#define PG8_STAGE(bufoff, gbase, voff) do { _Pragma("unroll") for (int _i = 0; _i < 2; ++_i) \
        __builtin_amdgcn_global_load_lds((const unsigned*)((const char*)(gbase) + (voff)[_i]), (PG8_LAS unsigned*)(lds + (bufoff) + ldsw + _i * 8192), 16, 0, 0); } while (0)
#define PG8_LDA(dst, b, h) do { _Pragma("unroll") for (int m = 0; m < 4; ++m) _Pragma("unroll") for (int k = 0; k < 2; ++k) dst[m][k] = *(const PG8_LAS bf16x8*)(lds + PG8_SA(b, h) + aoff + m * 2048 + k * 1024); } while (0)
#define PG8_LDB(dst, b, h) do { _Pragma("unroll") for (int n = 0; n < 2; ++n) _Pragma("unroll") for (int k = 0; k < 2; ++k) dst[n][k] = *(const PG8_LAS bf16x8*)(lds + PG8_SB(b, h) + boff + n * 2048 + k * 1024); } while (0)
#define PG8_MMA(ai, bj, At, Bt) do { __builtin_amdgcn_s_setprio(1); _Pragma("unroll") for (int m = 0; m < 4; ++m) _Pragma("unroll") for (int n = 0; n < 2; ++n) _Pragma("unroll") for (int k = 0; k < 2; ++k) \
        acc[ai][bj][m][n] = __builtin_amdgcn_mfma_f32_16x16x32_bf16(Bt[n][k], At[m][k], acc[ai][bj][m][n], 0, 0, 0); __builtin_amdgcn_s_setprio(0); } while (0)
#define PG8_WAIT_V(n) asm volatile("s_waitcnt vmcnt(" #n ")" ::: "memory")
#define PG8_WAIT_L(n) asm volatile("s_waitcnt lgkmcnt(" #n ")" ::: "memory")
#define PG8_BAR __builtin_amdgcn_s_barrier()
#define PG8_SCHED __builtin_amdgcn_sched_barrier(0)
    Unit cur, nxt; int ui = 0;
    if (!S.next(0, cur)) return;
    f32x4 acc[2][2][4][2];
#pragma unroll
    for (int a = 0; a < 2; ++a)
#pragma unroll
        for (int b = 0; b < 2; ++b)
#pragma unroll
            for (int m = 0; m < 4; ++m)
#pragma unroll
                for (int n = 0; n < 2; ++n) acc[a][b][m][n] = (f32x4){0.f, 0.f, 0.f, 0.f};
    bf16x8 At[4][2], B0[2][2], B1[2][2];
    const char* cA = (const char*)g.A + (size_t)cur.pm * tstep; const char* cB = (const char*)g.Bt + (size_t)cur.pn * tstep;
    S.a_ready(cur);
    E.rs_first(cur, lds, tid);
    if constexpr (SP2) {
        PG8_STAGE(PG8_SB(0, 0), cB, voffB); PG8_STAGE(PG8_SB(0, 1), cB + hstep, voffB); PG8_STAGE(PG8_SA(0, 0), cA, voffA); PG8_STAGE(PG8_SA(0, 1), cA + hstep, voffA);
        if (wr == 1) PG8_BAR;
        PG8_WAIT_V(2); PG8_BAR;
        PG8_STAGE(PG8_SB(1, 0), cB + kstep, voffB); PG8_STAGE(PG8_SA(1, 0), cA + kstep, voffA); PG8_STAGE(PG8_SB(1, 1), cB + hstep + kstep, voffB);
        PG8_WAIT_V(6); PG8_BAR;
    } else {
        PG8_STAGE(PG8_SB(0, 0), cB, voffB); PG8_STAGE(PG8_SA(0, 0), cA, voffA); PG8_STAGE(PG8_SB(0, 1), cB + hstep, voffB); PG8_STAGE(PG8_SA(0, 1), cA + hstep, voffA);
        if (wr == 1) PG8_BAR;
        PG8_WAIT_V(4); PG8_BAR;
        PG8_STAGE(PG8_SB(1, 0), cB + kstep, voffB); PG8_STAGE(PG8_SA(1, 0), cA + kstep, voffA); PG8_STAGE(PG8_SB(1, 1), cB + hstep + kstep, voffB);
        PG8_WAIT_V(6); PG8_BAR;
    }
    for (;;) {
        const bool has_next = S.next(ui + 1, nxt);
        const char* nA = has_next ? (const char*)g.A + (size_t)nxt.pm * tstep : cA; const char* nB = has_next ? (const char*)g.Bt + (size_t)nxt.pn * tstep : cB;
        for (int t = 0; t < nt; t += 2) {
            const bool last = (t == nt - 2);
            const char* a1 = cA + (size_t)(t + 1) * kstep;
            const char* a2 = last ? nA : cA + (size_t)(t + 2) * kstep; const char* b2 = last ? nB : cB + (size_t)(t + 2) * kstep;
            const char* a3 = a2 + kstep; const char* b3 = b2 + kstep;
            if (last && has_next) S.a_ready(nxt);
            if constexpr (SP2) {
            PG8_LDB(B0, 0, 0); PG8_LDB(B1, 0, 1); PG8_SCHED; PG8_LDA(At, 0, 0); PG8_STAGE(PG8_SA(1, 1), a1 + hstep, voffA);
            PG8_WAIT_V(8); PG8_WAIT_L(0); PG8_BAR; PG8_MMA(0, 0, At, B0); PG8_MMA(0, 1, At, B1); PG8_BAR; PG8_SCHED;
            PG8_LDA(At, 0, 1); PG8_STAGE(PG8_SB(0, 0), b2, voffB); PG8_STAGE(PG8_SB(0, 1), b2 + hstep, voffB); PG8_STAGE(PG8_SA(0, 0), a2, voffA);
            PG8_WAIT_V(8); PG8_WAIT_L(0); PG8_BAR; PG8_MMA(1, 0, At, B0); PG8_MMA(1, 1, At, B1); PG8_BAR; PG8_SCHED;
            PG8_LDB(B0, 1, 0); PG8_LDB(B1, 1, 1); PG8_SCHED; PG8_LDA(At, 1, 0); PG8_STAGE(PG8_SA(0, 1), a2 + hstep, voffA);
            PG8_WAIT_V(8); PG8_WAIT_L(0); PG8_BAR; PG8_MMA(0, 0, At, B0); PG8_MMA(0, 1, At, B1); PG8_BAR; PG8_SCHED;
            PG8_LDA(At, 1, 1); PG8_STAGE(PG8_SB(1, 0), b3, voffB); PG8_STAGE(PG8_SB(1, 1), b3 + hstep, voffB); PG8_STAGE(PG8_SA(1, 0), a3, voffA);
            PG8_WAIT_V(8); PG8_WAIT_L(0); PG8_BAR; PG8_MMA(1, 0, At, B0); PG8_MMA(1, 1, At, B1); PG8_BAR; PG8_SCHED;
            } else {
            PG8_LDB(B0, 0, 0); PG8_SCHED; PG8_LDA(At, 0, 0); PG8_STAGE(PG8_SA(1, 1), a1 + hstep, voffA);
            PG8_WAIT_L(8); PG8_BAR; PG8_WAIT_L(0); PG8_MMA(0, 0, At, B0); PG8_BAR; PG8_SCHED;
            PG8_LDB(B1, 0, 1); PG8_STAGE(PG8_SB(0, 0), b2, voffB);
            PG8_BAR; PG8_WAIT_L(0); PG8_MMA(0, 1, At, B1); PG8_BAR;
            PG8_LDA(At, 0, 1); PG8_STAGE(PG8_SA(0, 0), a2, voffA);
            PG8_BAR; PG8_WAIT_L(0); PG8_MMA(1, 0, At, B0); PG8_BAR; PG8_SCHED;
            PG8_STAGE(PG8_SB(0, 1), b2 + hstep, voffB);
            PG8_WAIT_V(6); PG8_BAR; PG8_MMA(1, 1, At, B1); PG8_BAR;
            PG8_LDB(B0, 1, 0); PG8_SCHED; PG8_LDA(At, 1, 0); PG8_STAGE(PG8_SA(0, 1), a2 + hstep, voffA);
            PG8_WAIT_L(8); PG8_BAR; PG8_WAIT_L(0); PG8_MMA(0, 0, At, B0); PG8_BAR; PG8_SCHED;
            PG8_LDB(B1, 1, 1); PG8_STAGE(PG8_SB(1, 0), b3, voffB);
            PG8_BAR; PG8_WAIT_L(0); PG8_MMA(0, 1, At, B1); PG8_BAR;
            PG8_LDA(At, 1, 1); PG8_STAGE(PG8_SA(1, 0), a3, voffA);
            PG8_BAR; PG8_WAIT_L(0); PG8_MMA(1, 0, At, B0); PG8_BAR; PG8_SCHED;
            PG8_STAGE(PG8_SB(1, 1), b3 + hstep, voffB);
            PG8_WAIT_V(6); PG8_BAR; PG8_MMA(1, 1, At, B1); PG8_BAR;
            }
        }
        if constexpr (ALIGN_EPI) { if (wr == 0) PG8_BAR; }
        if constexpr (!Epi::AFTER_DRAIN) { E(acc, cur, wr, wc, fr, fq, lds, tid, ui, nxt, has_next); S.done(cur); }
        if (!has_next) break;
#pragma unroll
        for (int a = 0; a < 2; ++a)
#pragma unroll
            for (int b = 0; b < 2; ++b)
#pragma unroll
                for (int m = 0; m < 4; ++m)
#pragma unroll
                    for (int n = 0; n < 2; ++n) acc[a][b][m][n] = (f32x4){0.f, 0.f, 0.f, 0.f};
        cur = nxt; cA = nA; cB = nB; ++ui;
        if constexpr (ALIGN_EPI) { if (wr == 1) PG8_BAR; }
    }
    PG8_WAIT_V(0);
    if constexpr (!ALIGN_EPI) { if (wr == 0) PG8_BAR; }
    PG8_BAR;
    if constexpr (Epi::AFTER_DRAIN) { E.fused(acc, cur, wr, wc, fr, fq, lds, wid, lane); S.done(cur); }
#undef PG8_SA
#undef PG8_SB
#undef PG8_STAGE
#undef PG8_LDA
#undef PG8_LDB
#undef PG8_MMA
#undef PG8_WAIT_V
#undef PG8_WAIT_L
#undef PG8_BAR
#undef PG8_SCHED
}
}

namespace mk {
using pg8::bf16_t; using pg8::bf16x8; using pg8::f32x4; using pg8::u32x4; using pg8::Unit; using pg8::cvt_pk_bf16;
#define LAS __attribute__((address_space(3)))
typedef float f32x16 __attribute__((ext_vector_type(16)));
typedef short v4i16_t __attribute__((ext_vector_type(4)));
#define XB_TMO      128
#define XB_XCNT(j)  (256  + 64 * (j))
#define XB_XSUB(j)  (1280 + 64 * (j))
#define XB_XGEN(j)  (2304 + 64 * (j))
#define XB_TOP      3328
#define XB_TOPGEN   3392
#define XCD_BAR_WORDS 3456
#define XB_SPIN_CAP (1u << 18)

__device__ __forceinline__ unsigned xb_ld(unsigned* p)              { return __hip_atomic_load(p, __ATOMIC_RELAXED, __HIP_MEMORY_SCOPE_AGENT); }
__device__ __forceinline__ unsigned xb_add(unsigned* p, unsigned v) { return __hip_atomic_fetch_add(p, v, __ATOMIC_RELAXED, __HIP_MEMORY_SCOPE_AGENT); }
__device__ __forceinline__ unsigned xb_xcc_id() { return (unsigned)__builtin_amdgcn_s_getreg((3 << 11) | 20) & 0xFu; }
#define XB_SPIN(cond, bar) do { unsigned _sp = 0; while (cond) { __builtin_amdgcn_s_sleep(1); \
    if ((++_sp & 255u) == 0u) { if (xb_ld(&(bar)[XB_TMO])) break; if (_sp > XB_SPIN_CAP) { atomicAdd(&(bar)[XB_TMO], 1u); break; } } } } while (0)

struct XcdBarrier {
    unsigned* bar; unsigned x;
    volatile LAS unsigned* st;
};

__device__ __forceinline__ XcdBarrier xcd_barrier_post(unsigned* bar, volatile LAS unsigned* st) {
    XcdBarrier b; b.bar = bar; b.x = xb_xcc_id(); b.st = st;
    if (threadIdx.x == 0) (void)xb_add(&bar[XB_XCNT(b.x)], 1u);
    return b;
}
__device__ __forceinline__ void xcd_barrier_complete(unsigned* bar, unsigned x, unsigned& nloc, unsigned& nx) {
    const unsigned G = gridDim.x * gridDim.y * gridDim.z;
    unsigned sum, cnt, mine, sp = 0u;
    for (;;) {
        sum = 0u; cnt = 0u; mine = 0u;
#pragma unroll
        for (unsigned j = 0; j < 16; ++j) { const unsigned c = xb_ld(&bar[XB_XCNT(j)]); sum += c; cnt += (c > 0u) ? 1u : 0u; mine = (j == x) ? c : mine; }
        if (sum == G) break;
        __builtin_amdgcn_s_sleep(1);
        if ((++sp & 255u) == 0u) { if (xb_ld(&bar[XB_TMO])) break; if (sp > XB_SPIN_CAP) { atomicAdd(&bar[XB_TMO], 1u); break; } }
    }
    nloc = mine > 0u ? mine : 1u; nx = cnt > 0u ? cnt : 1u;
}

__device__ __forceinline__ void xcd_barrier(const XcdBarrier& b) {
    asm volatile("s_waitcnt vmcnt(0)" ::: "memory");
    __syncthreads();
    if (threadIdx.x == 0) {
        unsigned* bar = b.bar;
        __builtin_amdgcn_s_waitcnt(0);
        unsigned nloc = b.st[0], nx = b.st[1];
        if (nloc == 0u) { xcd_barrier_complete(bar, b.x, nloc, nx); b.st[0] = nloc; b.st[1] = nx; }
        const unsigned old = xb_add(&bar[XB_XSUB(b.x)], 1u);
        const unsigned gen = old / nloc;
        if (old + 1u == (gen + 1u) * nloc) {
            __builtin_amdgcn_fence(__ATOMIC_RELEASE, "agent");
            asm volatile("s_waitcnt vmcnt(0)" ::: "memory");
            const unsigned og = xb_add(&bar[XB_TOP], 1u);
            const unsigned tg = og / nx;
            if (og + 1u == (tg + 1u) * nx) xb_add(&bar[XB_TOPGEN], 1u);
            else XB_SPIN(xb_ld(&bar[XB_TOPGEN]) == tg, bar);
            __builtin_amdgcn_fence(__ATOMIC_ACQUIRE, "agent");
            xb_add(&bar[XB_XGEN(b.x)], 1u);
            asm volatile("s_waitcnt vmcnt(0)" ::: "memory");
        } else {
            XB_SPIN(xb_ld(&bar[XB_XGEN(b.x)]) == gen, bar);
            __builtin_amdgcn_fence(__ATOMIC_ACQUIRE, "agent");
            asm volatile("s_waitcnt vmcnt(0)" ::: "memory");
        }
    }
    __syncthreads();
}

constexpr int M = 32768, D = 1024, FF = 2816, SEQ = 4096, NB = 8, NH = 16, HD = 64, CW = 31;
constexpr float RMS_EPS = 1e-6f, LN_EPS = 1e-5f, LOG2E = 1.4426950408889634f;
constexpr int NWAVES = 8, NTHREADS = 512;
constexpr int LDS_BYTES = 147456;

constexpr size_t MiB = 1u << 20;
constexpr size_t WS_SSP = 0;
constexpr size_t SSP_STRIDE = (size_t)M * 16;
constexpr size_t WS_BAR = 15 * MiB;
constexpr size_t WS_WIN = 16 * MiB;
constexpr size_t WIN_STRIDE = (size_t)2 * FF * D;
constexpr size_t WS_WOUT = WS_WIN + 4 * WIN_STRIDE * 2;
constexpr size_t WOUT_STRIDE = (size_t)D * FF;
constexpr size_t WS_WPW1 = WS_WOUT + 4 * WOUT_STRIDE * 2;
constexpr size_t WS_WPW2 = WS_WPW1 + (size_t)2 * D * D * 2;
constexpr size_t WS_WQKV = WS_WPW2 + (size_t)D * D * 2;
constexpr size_t WS_WO = WS_WQKV + (size_t)3 * D * D * 2;
constexpr size_t WS_XB = 98 * MiB;
constexpr size_t WS_R = 162 * MiB;
constexpr size_t WS_O = 354 * MiB;
constexpr size_t WS_END = 418 * MiB;
static_assert(WS_WO + (size_t)D * D * 2 <= WS_XB, "ws map");
static_assert((size_t)M * FF * 2 <= 192 * MiB, "ws map");

__device__ __forceinline__ float sigm(float x) { return __builtin_amdgcn_rcpf(1.f + __builtin_amdgcn_exp2f(-LOG2E * x)); }
__device__ __forceinline__ float wave_sum(float v) {
#pragma unroll
    for (int o = 1; o < 64; o <<= 1) v += __shfl_xor(v, o);
    return v;
}
__device__ __forceinline__ float row_rstd(const float* ssp, int row) {
    const f32x4* p = (const f32x4*)(ssp + (size_t)row * 16);
    f32x4 a = p[0], b = p[1], c = p[2], d = p[3]; a = (a + b) + (c + d);
    return rsqrtf(((a.x + a.y) + (a.z + a.w)) * (1.f / D) + RMS_EPS);
}

constexpr int RS_LDS_OFF = 131072;
__device__ __forceinline__ void rs_issue(const float* ssp, const Unit& u, int tid, f32x4& a, f32x4& b) { const float* p = ssp + (size_t)(u.pm * 256 + (tid >> 1)) * 16 + 8 * (tid & 1); a = *(const f32x4*)p; b = *(const f32x4*)(p + 4); }
__device__ __forceinline__ void rs_finish(LAS unsigned char* lds, int buf, int tid, const f32x4& a, const f32x4& b) {
    float t = ((a.x + a.y) + (a.z + a.w)) + ((b.x + b.y) + (b.z + b.w)); t += __shfl_xor(t, 1);
    if (!(tid & 1)) ((LAS float*)(lds + RS_LDS_OFF))[buf * 256 + (tid >> 1)] = rsqrtf(t * (1.f / D) + RMS_EPS);
}
__device__ __forceinline__ void rs_read(LAS unsigned char* lds, int buf, int wr, int fr, float (&rs)[2][4]) {
    const LAS float* t = (const LAS float*)(lds + RS_LDS_OFF) + buf * 256 + wr * 64 + fr;
#pragma unroll
    for (int ai = 0; ai < 2; ++ai)
#pragma unroll
        for (int m = 0; m < 4; ++m) rs[ai][m] = t[ai * 128 + m * 16];
}
struct EpiSwiGLU {
    static constexpr bool PERM = true, AFTER_DRAIN = false;
    bf16_t* O; const float* ssp;
    __device__ __forceinline__ void rs_first(const Unit& u, LAS unsigned char* lds, int tid) const { f32x4 a, b; rs_issue(ssp, u, tid, a, b); rs_finish(lds, 0, tid, a, b); }
    __device__ __forceinline__ void operator()(const f32x4 (&acc)[2][2][4][2], const Unit& u, int wr, int wc, int fr, int fq, LAS unsigned char* lds, int tid, int ui, const Unit& nxt, bool has_next) const {
        f32x4 na, nb; if (has_next) rs_issue(ssp, nxt, tid, na, nb);
        const int row0 = u.pm * 256 + wr * 64 + fr, col0 = u.pn * 128 + wc * 32 + 8 * fq;
        float rsv[2][4]; rs_read(lds, ui & 1, wr, fr, rsv);
#pragma unroll
        for (int ai = 0; ai < 2; ++ai)
#pragma unroll
            for (int m = 0; m < 4; ++m) {
                const int row = row0 + ai * 128 + m * 16;
                const float rs = rsv[ai][m];
                typedef float f32x2 __attribute__((ext_vector_type(2)));
                const f32x2 rs2 = (f32x2){rs, rs}, nrs2 = (f32x2){-LOG2E * rs, -LOG2E * rs};
                unsigned wv[4];
#pragma unroll
                for (int n = 0; n < 2; ++n)
#pragma unroll
                    for (int hp = 0; hp < 2; ++hp) {
                        const f32x2 ag = (f32x2){acc[ai][0][m][n][2 * hp], acc[ai][0][m][n][2 * hp + 1]}, au = (f32x2){acc[ai][1][m][n][2 * hp], acc[ai][1][m][n][2 * hp + 1]};
                        const f32x2 g = ag * rs2, up = au * rs2, ne = ag * nrs2;
                        const f32x2 dd = (f32x2){__builtin_amdgcn_exp2f(ne.x), __builtin_amdgcn_exp2f(ne.y)} + 1.0f;
                        const f32x2 rr = (f32x2){__builtin_amdgcn_rcpf(dd.x), __builtin_amdgcn_rcpf(dd.y)};
                        const f32x2 oo = (g * rr) * up;
                        wv[n * 2 + hp] = cvt_pk_bf16(oo.x, oo.y);
                    }
                u32x4 w; w.x = wv[0]; w.y = wv[1]; w.z = wv[2]; w.w = wv[3];
                __builtin_nontemporal_store(w, (u32x4*)(O + (size_t)row * FF + col0));
            }
        if (has_next) rs_finish(lds, (ui + 1) & 1, tid, na, nb);
    }
};
struct EpiGLU {
    static constexpr bool PERM = true, AFTER_DRAIN = false;
    bf16_t* O; const float* ssp; const float* bias;
    __device__ __forceinline__ void rs_first(const Unit& u, LAS unsigned char* lds, int tid) const { f32x4 a, b; rs_issue(ssp, u, tid, a, b); rs_finish(lds, 0, tid, a, b); }
    __device__ __forceinline__ void operator()(const f32x4 (&acc)[2][2][4][2], const Unit& u, int wr, int wc, int fr, int fq, LAS unsigned char* lds, int tid, int ui, const Unit& nxt, bool has_next) const {
        f32x4 na, nb; if (has_next) rs_issue(ssp, nxt, tid, na, nb);
        const int row0 = u.pm * 256 + wr * 64 + fr, col0 = u.pn * 128 + wc * 32 + 8 * fq;
        f32x4 bv[2][2];
#pragma unroll
        for (int bj = 0; bj < 2; ++bj)
#pragma unroll
            for (int n = 0; n < 2; ++n) bv[bj][n] = *(const f32x4*)(bias + bj * D + col0 + 4 * n);
        float rsv[2][4]; rs_read(lds, ui & 1, wr, fr, rsv);
#pragma unroll
        for (int ai = 0; ai < 2; ++ai)
#pragma unroll
            for (int m = 0; m < 4; ++m) {
                const int row = row0 + ai * 128 + m * 16;
                const float rs = rsv[ai][m];
                float o[8];
#pragma unroll
                for (int n = 0; n < 2; ++n)
#pragma unroll
                    for (int e = 0; e < 4; ++e) { const float v = acc[ai][0][m][n][e] * rs + bv[0][n][e], g = acc[ai][1][m][n][e] * rs + bv[1][n][e]; o[n * 4 + e] = v * sigm(g); }
                u32x4 w; w.x = cvt_pk_bf16(o[0], o[1]); w.y = cvt_pk_bf16(o[2], o[3]); w.z = cvt_pk_bf16(o[4], o[5]); w.w = cvt_pk_bf16(o[6], o[7]);
                *(u32x4*)(O + (size_t)row * D + col0) = w;
            }
        if (has_next) rs_finish(lds, (ui + 1) & 1, tid, na, nb);
    }
};
struct EpiQKV {
    static constexpr bool PERM = true, AFTER_DRAIN = false;
    bf16_t* O; const float* ssp;
    __device__ __forceinline__ void rs_first(const Unit& u, LAS unsigned char* lds, int tid) const { f32x4 a, b; rs_issue(ssp, u, tid, a, b); rs_finish(lds, 0, tid, a, b); }
    __device__ __forceinline__ void operator()(const f32x4 (&acc)[2][2][4][2], const Unit& u, int wr, int wc, int fr, int fq, LAS unsigned char* lds, int tid, int ui, const Unit& nxt, bool has_next) const {
        f32x4 na, nb; if (has_next) rs_issue(ssp, nxt, tid, na, nb);
        const int row0 = u.pm * 256 + wr * 64 + fr; const int t = u.pn >> 2;
        bf16_t* base = O + (size_t)t * M * D; const int col0 = (u.pn & 3) * 256 + wc * 32 + 8 * fq;
        float rsv[2][4]; rs_read(lds, ui & 1, wr, fr, rsv);
#pragma unroll
        for (int ai = 0; ai < 2; ++ai)
#pragma unroll
            for (int m = 0; m < 4; ++m) {
                const int row = row0 + ai * 128 + m * 16;
                const float rs = rsv[ai][m];
#pragma unroll
                for (int bj = 0; bj < 2; ++bj) {
                    const f32x4 v0 = acc[ai][bj][m][0] * rs, v1 = acc[ai][bj][m][1] * rs;
                    u32x4 w; w.x = cvt_pk_bf16(v0[0], v0[1]); w.y = cvt_pk_bf16(v0[2], v0[3]); w.z = cvt_pk_bf16(v1[0], v1[1]); w.w = cvt_pk_bf16(v1[2], v1[3]);
                    *(u32x4*)(base + (size_t)row * D + col0 + bj * 128) = w;
                }
            }
        if (has_next) rs_finish(lds, (ui + 1) & 1, tid, na, nb);
    }
};
struct EpiResid {
    static constexpr bool PERM = true, AFTER_DRAIN = false;
    bf16_t* xb; float* ssp; const float* bias; float alpha;
    __device__ __forceinline__ void rs_first(const Unit&, LAS unsigned char*, int) const {}
    __device__ __forceinline__ void operator()(const f32x4 (&acc)[2][2][4][2], const Unit& u, int wr, int wc, int fr, int fq, LAS unsigned char* lds, int tid, int ui, const Unit& nxt, bool has_next) const {
        const int row0 = u.pm * 256 + wr * 64 + fr, col0 = u.pn * 256 + wc * 32 + 8 * fq;
        f32x4 bv[2][2];
#pragma unroll
        for (int bj = 0; bj < 2; ++bj)
#pragma unroll
            for (int n = 0; n < 2; ++n) bv[bj][n] = bias ? *(const f32x4*)(bias + col0 + bj * 128 + 4 * n) : (f32x4){0.f, 0.f, 0.f, 0.f};
#pragma unroll
        for (int ai = 0; ai < 2; ++ai) {
            u32x4 xr[4][2];
#pragma unroll
            for (int m = 0; m < 4; ++m)
#pragma unroll
                for (int bj = 0; bj < 2; ++bj) xr[m][bj] = *(const u32x4*)(xb + (size_t)(row0 + ai * 128 + m * 16) * D + col0 + bj * 128);
#pragma unroll
            for (int m = 0; m < 4; ++m) {
                const int row = row0 + ai * 128 + m * 16; const size_t off = (size_t)row * D + col0;
                typedef float f32x2 __attribute__((ext_vector_type(2)));
                f32x2 sq2 = (f32x2){0.f, 0.f};
#pragma unroll
                for (int bj = 0; bj < 2; ++bj) {
                    f32x2 v[4];
                    const u32x4 w0 = xr[m][bj];
#pragma unroll
                    for (int i = 0; i < 4; ++i) v[i] = (f32x2){__uint_as_float(w0[i] << 16), __uint_as_float(w0[i] & 0xffff0000u)};
                    const f32x2 al2 = (f32x2){alpha, alpha};
                    unsigned wv[4];
#pragma unroll
                    for (int i = 0; i < 4; ++i) {
                        const f32x4 av = acc[ai][bj][m][i >> 1], bb = bv[bj][i >> 1];
                        const f32x2 a2 = (i & 1) ? (f32x2){av.z, av.w} : (f32x2){av.x, av.y}, b2 = (i & 1) ? (f32x2){bb.z, bb.w} : (f32x2){bb.x, bb.y};
                        v[i] = __builtin_elementwise_fma(a2, al2, v[i]) + b2;
                        sq2 = __builtin_elementwise_fma(v[i], v[i], sq2);
                        wv[i] = cvt_pk_bf16(v[i].x, v[i].y);
                    }
                    u32x4 w; w.x = wv[0]; w.y = wv[1]; w.z = wv[2]; w.w = wv[3];
                    *(u32x4*)(xb + off + bj * 128) = w;
                }
                float sq = sq2.x + sq2.y;
                sq += __shfl_xor(sq, 16); sq += __shfl_xor(sq, 32);
                if (fq == 0) ssp[(size_t)row * 16 + u.pn * 4 + wc] = sq;
            }
            asm volatile("" ::: "memory");
        }
    }
};

__device__ __forceinline__ void transpose_item(const float* W, int K, int N, const float* g, bf16_t* WT, int glu_h, LAS float* scr, int item, int lane) {
    const int nblk = N / 64, kb = item / nblk, nb = item % nblk, k0 = 64 * kb, n0 = 64 * nb;
    const int lr = lane >> 4, c4 = lane & 15;
    f32x4 v[16];
#pragma unroll
    for (int i = 0; i < 16; ++i) v[i] = __builtin_nontemporal_load((const f32x4*)(W + (size_t)(k0 + 4 * i + lr) * N + n0 + 4 * c4));
    if (g) {
#pragma unroll
        for (int i = 0; i < 16; ++i) v[i] = v[i] * g[k0 + 4 * i + lr];
    }
#pragma unroll
    for (int i = 0; i < 16; ++i) { LAS float* d = scr + (4 * i + lr) * 65 + 4 * c4; d[0] = v[i].x; d[1] = v[i].y; d[2] = v[i].z; d[3] = v[i].w; }
    asm volatile("s_waitcnt lgkmcnt(0)" ::: "memory");
    int drow0 = n0;
    if (glu_h) { const int up = n0 >= glu_h, c = up ? n0 - glu_h : n0; drow0 = (c >> 7) * 256 + up * 128 + (c & 127); }
    const int c = lane & 7;
#pragma unroll
    for (int j = 0; j < 8; ++j) { const int n = (lane >> 3) + 8 * j; const LAS float* p = scr + (8 * c) * 65 + n;
        u32x4 o; o.x = cvt_pk_bf16(p[0 * 65], p[1 * 65]); o.y = cvt_pk_bf16(p[2 * 65], p[3 * 65]); o.z = cvt_pk_bf16(p[4 * 65], p[5 * 65]); o.w = cvt_pk_bf16(p[6 * 65], p[7 * 65]);
        *(u32x4*)(WT + (size_t)(drow0 + n) * K + k0 + 8 * c) = o; }
    asm volatile("s_waitcnt lgkmcnt(0)" ::: "memory");
}

struct Ptrs {
    const float *x, *norm_g, *final_g, *ffn_w_in, *ffn_w_out, *w_pw1, *b_pw1, *w_dw, *b_dw, *ln_g, *ln_b, *w_pw2, *b_pw2, *w_qkv, *w_o;
    float* out; unsigned char* ws;
};

__device__ __forceinline__ void prologue(const Ptrs& P, LAS unsigned char* lds, int vcu, int G, int wave, int lane) {
    LAS float* scr = (LAS float*)(lds + wave * 18432);
    const int gw = vcu * NWAVES + wave, NGW = G * NWAVES;
    constexpr int I_IN = (D / 64) * (2 * FF / 64), I_OUT = (FF / 64) * (D / 64), I_PW1 = (D / 64) * (2 * D / 64), I_SQ = (D / 64) * (D / 64), I_QKV = (D / 64) * (3 * D / 64);
    constexpr int NITEMS = 4 * I_IN + 4 * I_OUT + I_PW1 + I_SQ + I_QKV + I_SQ;
    bf16_t* ws16 = (bf16_t*)P.ws;
    for (int it = gw; it < NITEMS; it += NGW) {
        int r = it; const float* W; const float* g = nullptr; bf16_t* WT; int K = D, N = D, glu = 0;
        if (r < 4 * I_IN) { const int idx = r / I_IN, l = idx >> 1, j = idx & 1; r -= idx * I_IN;
            W = P.ffn_w_in + (size_t)idx * D * 2 * FF; N = 2 * FF; g = P.norm_g + (l * 3 + (j ? 2 : 0)) * D; WT = (bf16_t*)(P.ws + WS_WIN) + idx * WIN_STRIDE; glu = FF; }
        else if ((r -= 4 * I_IN) < 4 * I_OUT) { const int idx = r / I_OUT; r -= idx * I_OUT;
            W = P.ffn_w_out + (size_t)idx * FF * D; K = FF; WT = (bf16_t*)(P.ws + WS_WOUT) + idx * WOUT_STRIDE; }
        else if ((r -= 4 * I_OUT) < I_PW1) { W = P.w_pw1; N = 2 * D; g = P.norm_g + 1 * D; WT = (bf16_t*)(P.ws + WS_WPW1); glu = D; }
        else if ((r -= I_PW1) < I_SQ) { W = P.w_pw2; WT = (bf16_t*)(P.ws + WS_WPW2); }
        else if ((r -= I_SQ) < I_QKV) { W = P.w_qkv; N = 3 * D; g = P.norm_g + 4 * D; WT = (bf16_t*)(P.ws + WS_WQKV); }
        else { r -= I_QKV; W = P.w_o; WT = (bf16_t*)(P.ws + WS_WO); }
        transpose_item(W, K, N, g, WT, glu, scr, r, lane);
    }
    (void)ws16;
    bf16_t* xb = (bf16_t*)(P.ws + WS_XB); float* ssp0 = (float*)(P.ws + WS_SSP);
    for (int m0 = gw; m0 < M; m0 += 2 * NGW) {
        f32x4 v[2][4]; float sq[2];
#pragma unroll
        for (int t = 0; t < 2; ++t) { const f32x4* xr = (const f32x4*)(P.x + (size_t)((t && m0 + NGW >= M) ? m0 : m0 + t * NGW) * D) + lane;
#pragma unroll
            for (int j = 0; j < 4; ++j) v[t][j] = __builtin_nontemporal_load(xr + 64 * j); }
#pragma unroll
        for (int t = 0; t < 2; ++t) { float s_ = 0.f;
#pragma unroll
            for (int j = 0; j < 4; ++j) s_ += (v[t][j].x * v[t][j].x + v[t][j].y * v[t][j].y) + (v[t][j].z * v[t][j].z + v[t][j].w * v[t][j].w);
            sq[t] = wave_sum(s_); }
#pragma unroll
        for (int t = 0; t < 2; ++t) { const int m = (t && m0 + NGW >= M) ? m0 : m0 + t * NGW;
            unsigned long long* o8 = (unsigned long long*)(xb + (size_t)m * D) + lane;
#pragma unroll
            for (int j = 0; j < 4; ++j) o8[64 * j] = (unsigned long long)cvt_pk_bf16(v[t][j].x, v[t][j].y) | ((unsigned long long)cvt_pk_bf16(v[t][j].z, v[t][j].w) << 32);
            if (lane < 16) ssp0[(size_t)m * 16 + lane] = lane == 0 ? sq[t] : 0.f; }
    }
}

__device__ __forceinline__ void conv_phase(LAS unsigned char* lds, const bf16_t* U, bf16_t* C, const float* wdw, const float* bdw, const float* lng, const float* lnb,
                                           int vcu, int G, int tid, int wave, int lane) {
    constexpr int TT = 32, ROWS = TT + CW - 1, NT = M / TT;
    for (int tile = vcu; tile < NT; tile += G) {
        const int t0 = tile * TT, tin = t0 % SEQ;
        for (int idx = tid; idx < ROWS * 128; idx += NTHREADS) {
            const int row = idx >> 7, ch = idx & 127;
            u32x4 v = (u32x4){0u, 0u, 0u, 0u};
            if (tin + row - (CW - 1) >= 0) v = *(const u32x4*)(U + (size_t)(t0 + row - (CW - 1)) * D + ch * 8);
            *(LAS u32x4*)(lds + row * 2048 + ch * 16) = v;
        }
        __syncthreads();
        typedef float f32x2 __attribute__((ext_vector_type(2)));
        f32x2 acc[2][4][4];
#pragma unroll
        for (int p = 0; p < 2; ++p) {
#pragma unroll
            for (int j = 0; j < 4; ++j)
#pragma unroll
                for (int c = 0; c < 4; ++c) acc[p][j][c] = (f32x2){0.f, 0.f};
            f32x4 wt[8][2];
            const float* wq = wdw + p * 512 + lane * 8;
#pragma unroll
            for (int t = 0; t < 4; ++t) { wt[t][0] = *(const f32x4*)(wq); wt[t][1] = *(const f32x4*)(wq + 4); wq += D; asm volatile("" : "+v"(wq)); }
#pragma unroll
            for (int r = 0; r < TT / NWAVES + CW - 1; ++r) {
                if (r + 4 < CW) { wt[(r + 4) & 7][0] = *(const f32x4*)(wq); wt[(r + 4) & 7][1] = *(const f32x4*)(wq + 4); wq += D; asm volatile("" : "+v"(wq)); }
                const u32x4 xv = *(const LAS u32x4*)(lds + (4 * wave + r) * 2048 + p * 1024 + lane * 16);
                f32x2 x[4];
#pragma unroll
                for (int i = 0; i < 4; ++i) x[i] = (f32x2){__uint_as_float(xv[i] << 16), __uint_as_float(xv[i] & 0xffff0000u)};
#pragma unroll
                for (int j = 0; j < 4; ++j) { const int w = r - j;
                    if (w >= 0 && w < CW) {
#pragma unroll
                        for (int c = 0; c < 4; ++c) { const f32x4 wv = wt[w & 7][c >> 1]; const f32x2 w2 = (c & 1) ? (f32x2){wv.z, wv.w} : (f32x2){wv.x, wv.y}; acc[p][j][c] = __builtin_elementwise_fma(w2, x[c], acc[p][j][c]); } } }
                asm volatile("" ::: "memory");
            }
            const f32x4 b0 = *(const f32x4*)(bdw + p * 512 + lane * 8), b1 = *(const f32x4*)(bdw + p * 512 + lane * 8 + 4);
#pragma unroll
            for (int j = 0; j < 4; ++j) { acc[p][j][0] += (f32x2){b0.x, b0.y}; acc[p][j][1] += (f32x2){b0.z, b0.w}; acc[p][j][2] += (f32x2){b1.x, b1.y}; acc[p][j][3] += (f32x2){b1.z, b1.w}; }
        }
        float mean[4], rstd[4];
#pragma unroll
        for (int j = 0; j < 4; ++j) { f32x2 s2 = (f32x2){0.f, 0.f};
#pragma unroll
            for (int p = 0; p < 2; ++p)
#pragma unroll
                for (int c = 0; c < 4; ++c) s2 += acc[p][j][c];
            mean[j] = wave_sum(s2.x + s2.y) * (1.f / D); f32x2 q2 = (f32x2){0.f, 0.f};
#pragma unroll
            for (int p = 0; p < 2; ++p)
#pragma unroll
                for (int c = 0; c < 4; ++c) { const f32x2 d = acc[p][j][c] - mean[j]; q2 += d * d; }
            rstd[j] = rsqrtf(wave_sum(q2.x + q2.y) * (1.f / D) + LN_EPS); }
#pragma unroll
        for (int p = 0; p < 2; ++p) {
            const f32x4 g0 = *(const f32x4*)(lng + p * 512 + lane * 8), g1 = *(const f32x4*)(lng + p * 512 + lane * 8 + 4);
            const f32x4 c0 = *(const f32x4*)(lnb + p * 512 + lane * 8), c1 = *(const f32x4*)(lnb + p * 512 + lane * 8 + 4);
            const float gg[8] = {g0.x, g0.y, g0.z, g0.w, g1.x, g1.y, g1.z, g1.w}, bb[8] = {c0.x, c0.y, c0.z, c0.w, c1.x, c1.y, c1.z, c1.w};
#pragma unroll
            for (int j = 0; j < 4; ++j) { float o[8];
#pragma unroll
                for (int c = 0; c < 8; ++c) { const float y = (acc[p][j][c >> 1][c & 1] - mean[j]) * rstd[j] * gg[c] + bb[c]; o[c] = y * sigm(y); }
                u32x4 w; w.x = cvt_pk_bf16(o[0], o[1]); w.y = cvt_pk_bf16(o[2], o[3]); w.z = cvt_pk_bf16(o[4], o[5]); w.w = cvt_pk_bf16(o[6], o[7]);
                *(u32x4*)(C + (size_t)(t0 + 4 * wave + j) * D + p * 512 + lane * 8) = w; }
        }
        __syncthreads();
    }
}

__device__ __forceinline__ void attn_phase(LAS unsigned char* lds, const bf16_t* Q, const bf16_t* Kp, const bf16_t* Vp, bf16_t* O, int vcu, int G, int wave, int lane) {
    const int r32 = lane & 31, hi = lane >> 5;
    LAS unsigned char* vl = lds + wave * 8704;
    LAS unsigned char* kl = vl + 4096;
    constexpr int NU = NB * NH * (SEQ / 32);
    const int trb = (4 * hi + ((lane & 15) >> 2)) * 128 + ((lane >> 4) & 1) * 32 + (lane & 3) * 8;
    for (int u = vcu * NWAVES + wave; u < NU; u += G * NWAVES) {
        const int bh = u >> 7, qblk = u & 127, b = bh >> 4, h = bh & 15;
        const size_t rowbase = (size_t)b * SEQ;
        const bf16_t* Qw = Q + (rowbase + qblk * 32 + r32) * D + h * HD + hi * 8;
        bf16x8 qr[4];
#pragma unroll
        for (int d0 = 0; d0 < 4; ++d0) qr[d0] = *(const bf16x8*)(Qw + d0 * 16);
        const bf16_t* Kl = Kp + (rowbase + (lane >> 3)) * D + h * HD + (lane & 7) * 8;
        const bf16_t* Vl = Vp + (rowbase + (lane >> 3)) * D + h * HD + (lane & 7) * 8;
        u32x4 kn[4]; u32x4 vn[4];
#pragma unroll
        for (int i = 0; i < 4; ++i) { kn[i] = *(const u32x4*)(Kl + (size_t)(qblk * 32 + 8 * i) * D); vn[i] = *(const u32x4*)(Vl + (size_t)(qblk * 32 + 8 * i) * D); }
        f32x16 o0 = {}, o1 = {}; float carry = 1.f;
        for (int kt = qblk; kt >= 0; --kt) {
#pragma unroll
            for (int i = 0; i < 4; ++i) { *(LAS u32x4*)(vl + ((lane >> 3) + 8 * i) * 128 + (lane & 7) * 16) = vn[i]; *(LAS u32x4*)(kl + ((lane >> 3) + 8 * i) * 144 + (lane & 7) * 16) = kn[i]; }
            bf16x8 kc[4];
#pragma unroll
            for (int i = 0; i < 4; ++i) kc[i] = *(const LAS bf16x8*)(kl + r32 * 144 + i * 32 + hi * 16);
            if (kt > 0) {
#pragma unroll
                for (int i = 0; i < 4; ++i) { kn[i] = *(const u32x4*)(Kl + (size_t)((kt - 1) * 32 + 8 * i) * D); vn[i] = *(const u32x4*)(Vl + (size_t)((kt - 1) * 32 + 8 * i) * D); }
            }
            f32x16 p = {};
#pragma unroll
            for (int d0 = 0; d0 < 4; ++d0) p = __builtin_amdgcn_mfma_f32_32x32x16_bf16(kc[d0], qr[d0], p, 0, 0, 0);
            const bool diag = (kt == qblk);
            float beta[16], om[16];
#pragma unroll
            for (int r = 0; r < 16; ++r) {
                const float z = p[r] * 0.125f, e = __builtin_amdgcn_exp2f(-LOG2E * __builtin_fabsf(z)), rc = __builtin_amdgcn_rcpf(1.f + e), sm = e * rc;
                const bool pos = z >= 0.f; float bt = pos ? rc : sm, o_ = pos ? sm : rc;
                const int kvl = (r & 3) + 8 * (r >> 2) + 4 * hi;
                if (diag && kvl >= r32) { bt = 0.f; o_ = 1.f; }
                beta[r] = bt; om[r] = o_;
            }
            float Gm[4], Gp[4];
#pragma unroll
            for (int g = 0; g < 4; ++g) { Gm[g] = (om[4 * g] * om[4 * g + 1]) * (om[4 * g + 2] * om[4 * g + 3]); Gp[g] = __shfl_xor(Gm[g], 32); }
            float SO[4], SP[4];
            SO[3] = 1.f; SO[2] = Gm[3]; SO[1] = SO[2] * Gm[2]; SO[0] = SO[1] * Gm[1];
            SP[3] = 1.f; SP[2] = Gp[3]; SP[1] = SP[2] * Gp[2]; SP[0] = SP[1] * Gp[1];
            float A[16];
#pragma unroll
            for (int g = 0; g < 4; ++g) {
                const float E = carry * SO[g] * (hi ? SP[g] : SP[g] * Gp[g]);
                const float P3 = E, P2 = P3 * om[4 * g + 3], P1 = P2 * om[4 * g + 2], P0 = P1 * om[4 * g + 1];
                A[4 * g + 3] = beta[4 * g + 3] * P3; A[4 * g + 2] = beta[4 * g + 2] * P2; A[4 * g + 1] = beta[4 * g + 1] * P1; A[4 * g] = beta[4 * g] * P0;
            }
            carry = carry * (SO[0] * Gm[0]) * (SP[0] * Gp[0]);
            u32x4 pw0, pw1;
            pw0.x = cvt_pk_bf16(A[0], A[1]); pw0.y = cvt_pk_bf16(A[2], A[3]); pw0.z = cvt_pk_bf16(A[4], A[5]); pw0.w = cvt_pk_bf16(A[6], A[7]);
            pw1.x = cvt_pk_bf16(A[8], A[9]); pw1.y = cvt_pk_bf16(A[10], A[11]); pw1.z = cvt_pk_bf16(A[12], A[13]); pw1.w = cvt_pk_bf16(A[14], A[15]);
            const bf16x8 pa0 = __builtin_bit_cast(bf16x8, pw0), pa1 = __builtin_bit_cast(bf16x8, pw1);
            asm volatile("s_waitcnt lgkmcnt(0)" ::: "memory");
#pragma unroll
            for (int s = 0; s < 2; ++s)
#pragma unroll
                for (int d0 = 0; d0 < 2; ++d0) {
                    const v4i16_t lo = __builtin_amdgcn_ds_read_tr16_b64_v4i16((LAS v4i16_t*)(vl + trb + s * 2048 + d0 * 64));
                    const v4i16_t hh = __builtin_amdgcn_ds_read_tr16_b64_v4i16((LAS v4i16_t*)(vl + trb + s * 2048 + 1024 + d0 * 64));
                    const bf16x8 vf = (bf16x8){lo[0], lo[1], lo[2], lo[3], hh[0], hh[1], hh[2], hh[3]};
                    if (d0 == 0) o0 = __builtin_amdgcn_mfma_f32_32x32x16_bf16(s ? pa1 : pa0, vf, o0, 0, 0, 0);
                    else         o1 = __builtin_amdgcn_mfma_f32_32x32x16_bf16(s ? pa1 : pa0, vf, o1, 0, 0, 0);
                }
            asm volatile("s_waitcnt lgkmcnt(0)" ::: "memory");
            if (__builtin_amdgcn_ballot_w64(carry > 5.4210109e-20f) == 0ull) break;
        }
        bf16_t* Ow = O + (rowbase + qblk * 32) * D + h * HD + r32;
#pragma unroll
        for (int r = 0; r < 16; ++r) { const int q = (r & 3) + 8 * (r >> 2) + 4 * hi;
            const unsigned w = cvt_pk_bf16(o0[r], o1[r]);
            Ow[(size_t)q * D] = (bf16_t)(w & 0xffffu); Ow[(size_t)q * D + 32] = (bf16_t)(w >> 16); }
    }
}

struct Args { const float* in[15]; float* out; unsigned char* ws; };

__global__ void __launch_bounds__(NTHREADS, 2) mk_fwd(Args a) {
    extern __shared__ __attribute__((aligned(16))) unsigned char lds_[];
    LAS unsigned char* lds = (LAS unsigned char*)lds_;
    cg::grid_group grid = cg::this_grid();
    int tid = threadIdx.x, lane = tid & 63, wave = __builtin_amdgcn_readfirstlane(tid >> 6);
    const int G = gridDim.x, bx = blockIdx.x, vcu = (G % 8 == 0) ? (bx % 8) * (G / 8) + bx / 8 : bx;
    Ptrs P;
    P.x = a.in[0]; P.norm_g = a.in[1]; P.final_g = a.in[2]; P.ffn_w_in = a.in[3]; P.ffn_w_out = a.in[4]; P.w_pw1 = a.in[5]; P.b_pw1 = a.in[6]; P.w_dw = a.in[7]; P.b_dw = a.in[8];
    P.ln_g = a.in[9]; P.ln_b = a.in[10]; P.w_pw2 = a.in[11]; P.b_pw2 = a.in[12]; P.w_qkv = a.in[13]; P.w_o = a.in[14]; P.out = a.out; P.ws = a.ws;
    float* ssp = (float*)(P.ws + WS_SSP);
    bf16_t* Win = (bf16_t*)(P.ws + WS_WIN); bf16_t* Wout = (bf16_t*)(P.ws + WS_WOUT);
    bf16_t* Wpw1 = (bf16_t*)(P.ws + WS_WPW1); bf16_t* Wpw2 = (bf16_t*)(P.ws + WS_WPW2); bf16_t* Wqkv = (bf16_t*)(P.ws + WS_WQKV); bf16_t* Wo = (bf16_t*)(P.ws + WS_WO);
    bf16_t* xb = (bf16_t*)(P.ws + WS_XB); bf16_t* R = (bf16_t*)(P.ws + WS_R); bf16_t* Ob = (bf16_t*)(P.ws + WS_O);
    bf16_t* act = R; bf16_t* ub = R; bf16_t* cb = R + (size_t)M * D; bf16_t* qb = R; bf16_t* kb = R + (size_t)M * D; bf16_t* vb = R + (size_t)2 * M * D;

    prologue(P, lds, vcu, G, wave, lane);
    unsigned* barw = (unsigned*)(P.ws + WS_BAR);
    if (bx == 0) { for (int i = threadIdx.x; i < XCD_BAR_WORDS; i += NTHREADS) __hip_atomic_store(barw + i, 0u, __ATOMIC_RELAXED, __HIP_MEMORY_SCOPE_AGENT); }
    volatile LAS unsigned* bst = (volatile LAS unsigned*)(lds + LDS_BYTES - 16);
    if (threadIdx.x < 2) bst[threadIdx.x] = 0u;
    grid.sync();
    const XcdBarrier bar = xcd_barrier_post(barw, bst);

#pragma unroll 1
    for (int l = 0; l < 2; ++l) {
#pragma unroll 1
        for (int s = 0; s < 7; ++s) {
            tid = threadIdx.x; asm volatile("" : "+v"(tid)); lane = tid & 63; wave = __builtin_amdgcn_readfirstlane(tid >> 6);
            if (s == 0 || s == 5) {
                const int j = s == 0 ? 0 : 1;
                pg8::Gemm g{xb, Win + (size_t)(l * 2 + j) * WIN_STRIDE, M, 2 * FF, D}; pg8::StaticOrder S; S.init(M, 2 * FF, G, bx);
                EpiSwiGLU E{act, ssp + (size_t)(3 * l + (j ? 2 : 0)) * SSP_STRIDE};
                pg8::gemm_phase<EpiSwiGLU, pg8::StaticOrder, true, true>(lds, g, S, E);
            } else if (s == 1 || s == 4 || s == 6) {
                const bf16_t* A; const bf16_t* W; int K; float alpha; const float* bias; int so;
                if (s == 4) { A = l == 0 ? cb : Ob; W = l == 0 ? Wpw2 : Wo; K = D; alpha = 1.f; bias = l == 0 ? P.b_pw2 : nullptr; so = 3 * l + 2; }
                else { const int j = s == 1 ? 0 : 1; A = act; W = Wout + (size_t)(l * 2 + j) * WOUT_STRIDE; K = FF; alpha = 0.5f; bias = nullptr; so = 3 * l + (j ? 3 : 1); }
                pg8::Gemm g{A, W, M, D, K}; pg8::StaticOrder S; S.init(M, D, G, bx);
                EpiResid E{xb, ssp + (size_t)so * SSP_STRIDE, bias, alpha};
                pg8::gemm_phase<EpiResid, pg8::StaticOrder, true, true>(lds, g, S, E);
            } else if (s == 2) {
                if (l == 0) {
                    pg8::Gemm g{xb, Wpw1, M, 2 * D, D}; pg8::StaticOrder S; S.init(M, 2 * D, G, bx);
                    EpiGLU E{ub, ssp + (size_t)1 * SSP_STRIDE, P.b_pw1};
                    pg8::gemm_phase<EpiGLU, pg8::StaticOrder, true, true>(lds, g, S, E);
                } else {
                    pg8::Gemm g{xb, Wqkv, M, 3 * D, D}; pg8::StaticOrder S; S.init(M, 3 * D, G, bx);
                    EpiQKV E{qb, ssp + (size_t)4 * SSP_STRIDE};
                    pg8::gemm_phase<EpiQKV, pg8::StaticOrder, true, true>(lds, g, S, E);
                }
            } else {
                if (l == 0) conv_phase(lds, ub, cb, P.w_dw, P.b_dw, P.ln_g, P.ln_b, vcu, G, tid, wave, lane);
                if (l == 1) attn_phase(lds, qb, kb, vb, Ob, vcu, G, wave, lane);
            }
            xcd_barrier(bar);
        }
    }
    {
        const float* ss6 = ssp + (size_t)6 * SSP_STRIDE; const int gw = vcu * NWAVES + wave, NGW = G * NWAVES;
        f32x4 gv[2][2];
#pragma unroll
        for (int p = 0; p < 2; ++p) { gv[p][0] = *(const f32x4*)(P.final_g + p * 512 + lane * 8); gv[p][1] = *(const f32x4*)(P.final_g + p * 512 + lane * 8 + 4); }
        for (int m = gw; m < M; m += NGW) {
            const float rs = row_rstd(ss6, m);
#pragma unroll
            for (int p = 0; p < 2; ++p) {
                const u32x4 w = *(const u32x4*)(xb + (size_t)m * D + p * 512 + lane * 8);
                const f32x4 v0 = (f32x4){__uint_as_float(w.x << 16), __uint_as_float(w.x & 0xffff0000u), __uint_as_float(w.y << 16), __uint_as_float(w.y & 0xffff0000u)};
                const f32x4 v1 = (f32x4){__uint_as_float(w.z << 16), __uint_as_float(w.z & 0xffff0000u), __uint_as_float(w.w << 16), __uint_as_float(w.w & 0xffff0000u)};
                float* o = P.out + (size_t)m * D + p * 512 + lane * 8;
                __builtin_nontemporal_store(v0 * rs * gv[p][0], (f32x4*)o); __builtin_nontemporal_store(v1 * rs * gv[p][1], (f32x4*)(o + 4));
            }
        }
    }
}
}

extern "C" void kernel_launch(void* const* d_in, const int* in_sizes, int n_in, void* d_out, int out_size, void* d_ws, size_t ws_size, hipStream_t stream) {
    static int grid = 0;
    if (grid == 0) {
        if (n_in != 15 || in_sizes[0] != mk::M * mk::D || out_size != mk::M * mk::D || ws_size < mk::WS_END) {
            fprintf(stderr, "kernel_launch: unexpected shapes (n_in %d, in0 %d, out %d, ws %zu); nothing launched\n", n_in, n_in > 0 ? in_sizes[0] : -1, out_size, ws_size); grid = -1; return; }
        int dev = 0, cus = 0, per_cu = 0;
        if (hipGetDevice(&dev) != hipSuccess || hipDeviceGetAttribute(&cus, hipDeviceAttributeMultiprocessorCount, dev) != hipSuccess) { grid = -1; return; }
        if (hipFuncSetAttribute((const void*)mk::mk_fwd, hipFuncAttributeMaxDynamicSharedMemorySize, mk::LDS_BYTES) != hipSuccess) { fprintf(stderr, "kernel_launch: hipFuncSetAttribute failed\n"); grid = -1; return; }
        if (hipOccupancyMaxActiveBlocksPerMultiprocessor(&per_cu, (const void*)mk::mk_fwd, mk::NTHREADS, mk::LDS_BYTES) != hipSuccess || per_cu < 1) { fprintf(stderr, "kernel_launch: occupancy query says %d\n", per_cu); per_cu = 1; }
        (void)hipGetLastError();
        grid = cus * per_cu;
    }
    if (grid < 0) return;
    mk::Args a{};
    for (int i = 0; i < 15; ++i) a.in[i] = (const float*)d_in[i];
    a.out = (float*)d_out; a.ws = (unsigned char*)d_ws;
    void* args[] = {&a};
    hipError_t e = hipLaunchCooperativeKernel((const void*)mk::mk_fwd, dim3(grid), dim3(mk::NTHREADS), args, mk::LDS_BYTES, stream);
    if (e != hipSuccess) fprintf(stderr, "kernel_launch: cooperative launch failed: %s (grid %d)\n", hipGetErrorString(e), grid);
}
```

```cpp
#include <hip/hip_runtime.h>
#include <hip/hip_cooperative_groups.h>
#include <cstdio>
#include <cstdint>
namespace cg = cooperative_groups;
namespace pg8 {
#define PG8_LAS __attribute__((address_space(3)))
typedef unsigned short bf16_t;
typedef short bf16x8 __attribute__((ext_vector_type(8)));
typedef float f32x4 __attribute__((ext_vector_type(4)));
typedef unsigned u32x4 __attribute__((ext_vector_type(4)));
constexpr int BM = 256, BK = 64, HALF = 128, HTB = HALF * BK * 2  , STAGE_BYTES = 8 * HTB, NXCD = 8, WGM = 8;

__host__ __device__ __forceinline__ int lds_byte(int r, int c) { const int st = (r >> 4) * 2 + (c >> 5), rr = r & 15, cc = c & 31, ob = rr * 64 + cc * 2; return st * 1024 + (ob ^ (((ob >> 9) & 1) << 5)); }
__host__ __device__ __forceinline__ void stage_rc(int b, int& R, int& C) { const int st = b / 1024, sb = b % 1024, swz = sb ^ (((sb >> 9) & 1) << 5); R = (st >> 1) * 16 + swz / 64; C = (st & 1) * 32 + (swz % 64) / 2; }
__host__ __device__ __forceinline__ int perm32(int rho) { const int n = rho >> 4, i = rho & 15; return 8 * (i >> 2) + 4 * n + (i & 3); }

struct Unit { int pm, pn; };
struct Gemm { const bf16_t* A; const bf16_t* Bt; int M, N, K; };

struct StaticOrder {
    int nM, nN, nwg, G, c;
    __host__ __device__ void init(int M, int N, int G_, int c_) { nM = M / BM; nN = N / BM; nwg = nM * nN; G = G_; c = c_; }
    __host__ __device__ bool next(int i, Unit& u) const {
        const long L = (long)i * G + c; if (L >= nwg) return false;
        int wgid = (int)L; { const int q = nwg / NXCD, r = nwg % NXCD, xcd = wgid % NXCD, off = wgid / NXCD; wgid = (xcd < r ? xcd * (q + 1) : r * (q + 1) + (xcd - r) * q) + off; }
        const int nig = WGM * nN, gid = wgid / nig, fm = gid * WGM, gsz = (nM - fm) < WGM ? (nM - fm) : WGM;
        u.pm = fm + ((wgid % nig) % gsz); u.pn = (wgid % nig) / gsz; return true;
    }
    __device__ __forceinline__ void a_ready(const Unit&) const {}
    __device__ __forceinline__ void done(const Unit&) const {}
};

__device__ __forceinline__ unsigned cvt_pk_bf16(float lo, float hi) { unsigned r; asm volatile("v_cvt_pk_bf16_f32 %0, %1, %2" : "=v"(r) : "v"(lo), "v"(hi)); return r; }
template <class Epi, class Sched, bool ALIGN_EPI = false, bool SP2 = false>
__device__ __forceinline__ void gemm_phase(PG8_LAS unsigned char* lds, const Gemm g, const Sched& S, const Epi& E) {
    int tid_ = threadIdx.x; asm volatile("" : "+v"(tid_));
    const int tid = tid_, wid = __builtin_amdgcn_readfirstlane(tid >> 6), lane = tid & 63, wr = wid >> 2, wc = wid & 3, fr = lane & 15, fq = lane >> 4;
    const int K = g.K, nt = K / BK;
    unsigned voffA[2], voffB[2];
#pragma unroll
    for (int i = 0; i < 2; ++i) { int R, C; stage_rc(tid * 16 + i * 8192, R, C); const int Rb = Epi::PERM ? ((R & ~31) + perm32(R & 31)) : R;
        voffA[i] = (unsigned)(R * K + C) * 2u; voffB[i] = (unsigned)(Rb * K + C) * 2u; }
    const size_t kstep = (size_t)(BK * 2);
    const size_t hstep = (size_t)HALF * K * 2;
    const size_t tstep = 2 * hstep;
    const unsigned ldsw = (unsigned)wid * 1024u;
    const int aoff = lds_byte(wr * 64 + fr, fq * 8), boff = lds_byte(wc * 32 + fr, fq * 8);
#define PG8_SA(b, h) (((b) * 2 + (h)) * HTB)
#define PG8_SB(b, h) ((4 + (b) * 2 + (h)) * HTB)
#define PG8_STAGE(bufoff, gbase, voff) do { _Pragma("unroll") for (int _i = 0; _i < 2; ++_i) \
        __builtin_amdgcn_global_load_lds((const unsigned*)((const char*)(gbase) + (voff)[_i]), (PG8_LAS unsigned*)(lds + (bufoff) + ldsw + _i * 8192), 16, 0, 0); } while (0)
#define PG8_LDA(dst, b, h) do { _Pragma("unroll") for (int m = 0; m < 4; ++m) _Pragma("unroll") for (int k = 0; k < 2; ++k) dst[m][k] = *(const PG8_LAS bf16x8*)(lds + PG8_SA(b, h) + aoff + m * 2048 + k * 1024); } while (0)
#define PG8_LDB(dst, b, h) do { _Pragma("unroll") for (int n = 0; n < 2; ++n) _Pragma("unroll") for (int k = 0; k < 2; ++k) dst[n][k] = *(const PG8_LAS bf16x8*)(lds + PG8_SB(b, h) + boff + n * 2048 + k * 1024); } while (0)
#define PG8_MMA(ai, bj, At, Bt) do { __builtin_amdgcn_s_setprio(1); _Pragma("unroll") for (int m = 0; m < 4; ++m) _Pragma("unroll") for (int n = 0; n < 2; ++n) _Pragma("unroll") for (int k = 0; k < 2; ++k) \
        acc[ai][bj][m][n] = __builtin_amdgcn_mfma_f32_16x16x32_bf16(Bt[n][k], At[m][k], acc[ai][bj][m][n], 0, 0, 0); __builtin_amdgcn_s_setprio(0); } while (0)
#define PG8_WAIT_V(n) asm volatile("s_waitcnt vmcnt(" #n ")" ::: "memory")
#define PG8_WAIT_L(n) asm volatile("s_waitcnt lgkmcnt(" #n ")" ::: "memory")
#define PG8_BAR __builtin_amdgcn_s_barrier()
#define PG8_SCHED __builtin_amdgcn_sched_barrier(0)
    Unit cur, nxt; int ui = 0;
    if (!S.next(0, cur)) return;
    f32x4 acc[2][2][4][2];
#pragma unroll
    for (int a = 0; a < 2; ++a)
#pragma unroll
        for (int b = 0; b < 2; ++b)
#pragma unroll
            for (int m = 0; m < 4; ++m)
#pragma unroll
                for (int n = 0; n < 2; ++n) acc[a][b][m][n] = (f32x4){0.f, 0.f, 0.f, 0.f};
    bf16x8 At[4][2], B0[2][2], B1[2][2];
    const char* cA = (const char*)g.A + (size_t)cur.pm * tstep; const char* cB = (const char*)g.Bt + (size_t)cur.pn * tstep;
    S.a_ready(cur);
    E.rs_first(cur, lds, tid);
    if constexpr (SP2) {
        PG8_STAGE(PG8_SB(0, 0), cB, voffB); PG8_STAGE(PG8_SB(0, 1), cB + hstep, voffB); PG8_STAGE(PG8_SA(0, 0), cA, voffA); PG8_STAGE(PG8_SA(0, 1), cA + hstep, voffA);
        if (wr == 1) PG8_BAR;
        PG8_WAIT_V(2); PG8_BAR;
        PG8_STAGE(PG8_SB(1, 0), cB + kstep, voffB); PG8_STAGE(PG8_SA(1, 0), cA + kstep, voffA); PG8_STAGE(PG8_SB(1, 1), cB + hstep + kstep, voffB);
        PG8_WAIT_V(6); PG8_BAR;
    } else {
        PG8_STAGE(PG8_SB(0, 0), cB, voffB); PG8_STAGE(PG8_SA(0, 0), cA, voffA); PG8_STAGE(PG8_SB(0, 1), cB + hstep, voffB); PG8_STAGE(PG8_SA(0, 1), cA + hstep, voffA);
        if (wr == 1) PG8_BAR;
        PG8_WAIT_V(4); PG8_BAR;
        PG8_STAGE(PG8_SB(1, 0), cB + kstep, voffB); PG8_STAGE(PG8_SA(1, 0), cA + kstep, voffA); PG8_STAGE(PG8_SB(1, 1), cB + hstep + kstep, voffB);
        PG8_WAIT_V(6); PG8_BAR;
    }
    for (;;) {
        const bool has_next = S.next(ui + 1, nxt);
        const char* nA = has_next ? (const char*)g.A + (size_t)nxt.pm * tstep : cA; const char* nB = has_next ? (const char*)g.Bt + (size_t)nxt.pn * tstep : cB;
        for (int t = 0; t < nt; t += 2) {
            const bool last = (t == nt - 2);
            const char* a1 = cA + (size_t)(t + 1) * kstep;
            const char* a2 = last ? nA : cA + (size_t)(t + 2) * kstep; const char* b2 = last ? nB : cB + (size_t)(t + 2) * kstep;
            const char* a3 = a2 + kstep; const char* b3 = b2 + kstep;
            if (last && has_next) S.a_ready(nxt);
            if constexpr (SP2) {
            const int relax = __builtin_amdgcn_readfirstlane((t == 0 && ui > 0) ? 1 : 0);
            PG8_LDB(B0, 0, 0); PG8_LDB(B1, 0, 1); PG8_SCHED; PG8_LDA(At, 0, 0); PG8_STAGE(PG8_SA(1, 1), a1 + hstep, voffA);
            asm volatile("s_cmp_lg_u32 %0, 0\n\ts_cbranch_scc1 .Lrelax%=\n\ts_waitcnt vmcnt(8)\n.Lrelax%=:\n\ts_waitcnt vmcnt(%1)" :: "s"(relax), "n"(8 + Epi::NST) : "memory", "scc");
            PG8_WAIT_L(0); PG8_BAR; PG8_MMA(0, 0, At, B0); PG8_MMA(0, 1, At, B1); PG8_BAR; PG8_SCHED;
            PG8_LDA(At, 0, 1); PG8_STAGE(PG8_SB(0, 0), b2, voffB); PG8_STAGE(PG8_SB(0, 1), b2 + hstep, voffB); PG8_STAGE(PG8_SA(0, 0), a2, voffA);
            asm volatile("s_cmp_lg_u32 %0, 0\n\ts_cbranch_scc1 .Lrelax%=\n\ts_waitcnt vmcnt(8)\n.Lrelax%=:\n\ts_waitcnt vmcnt(%1)" :: "s"(relax), "n"(8 + Epi::NST) : "memory", "scc");
            PG8_WAIT_L(0); PG8_BAR; PG8_MMA(1, 0, At, B0); PG8_MMA(1, 1, At, B1); PG8_BAR; PG8_SCHED;
            PG8_LDB(B0, 1, 0); PG8_LDB(B1, 1, 1); PG8_SCHED; PG8_LDA(At, 1, 0); PG8_STAGE(PG8_SA(0, 1), a2 + hstep, voffA);
            PG8_WAIT_V(8); PG8_WAIT_L(0); PG8_BAR; PG8_MMA(0, 0, At, B0); PG8_MMA(0, 1, At, B1); PG8_BAR; PG8_SCHED;
            PG8_LDA(At, 1, 1); PG8_STAGE(PG8_SB(1, 0), b3, voffB); PG8_STAGE(PG8_SB(1, 1), b3 + hstep, voffB); PG8_STAGE(PG8_SA(1, 0), a3, voffA);
            PG8_WAIT_V(8); PG8_WAIT_L(0); PG8_BAR; PG8_MMA(1, 0, At, B0); PG8_MMA(1, 1, At, B1); PG8_BAR; PG8_SCHED;
            } else {
            PG8_LDB(B0, 0, 0); PG8_SCHED; PG8_LDA(At, 0, 0); PG8_STAGE(PG8_SA(1, 1), a1 + hstep, voffA);
            PG8_WAIT_L(8); PG8_BAR; PG8_WAIT_L(0); PG8_MMA(0, 0, At, B0); PG8_BAR; PG8_SCHED;
            PG8_LDB(B1, 0, 1); PG8_STAGE(PG8_SB(0, 0), b2, voffB);
            PG8_BAR; PG8_WAIT_L(0); PG8_MMA(0, 1, At, B1); PG8_BAR;
            PG8_LDA(At, 0, 1); PG8_STAGE(PG8_SA(0, 0), a2, voffA);
            PG8_BAR; PG8_WAIT_L(0); PG8_MMA(1, 0, At, B0); PG8_BAR; PG8_SCHED;
            PG8_STAGE(PG8_SB(0, 1), b2 + hstep, voffB);
            PG8_WAIT_V(6); PG8_BAR; PG8_MMA(1, 1, At, B1); PG8_BAR;
            PG8_LDB(B0, 1, 0); PG8_SCHED; PG8_LDA(At, 1, 0); PG8_STAGE(PG8_SA(0, 1), a2 + hstep, voffA);
            PG8_WAIT_L(8); PG8_BAR; PG8_WAIT_L(0); PG8_MMA(0, 0, At, B0); PG8_BAR; PG8_SCHED;
            PG8_LDB(B1, 1, 1); PG8_STAGE(PG8_SB(1, 0), b3, voffB);
            PG8_BAR; PG8_WAIT_L(0); PG8_MMA(0, 1, At, B1); PG8_BAR;
            PG8_LDA(At, 1, 1); PG8_STAGE(PG8_SA(1, 0), a3, voffA);
            PG8_BAR; PG8_WAIT_L(0); PG8_MMA(1, 0, At, B0); PG8_BAR; PG8_SCHED;
            PG8_STAGE(PG8_SB(1, 1), b3 + hstep, voffB);
            PG8_WAIT_V(6); PG8_BAR; PG8_MMA(1, 1, At, B1); PG8_BAR;
            }
        }
        if constexpr (ALIGN_EPI) { if (wr == 0) PG8_BAR; }
        if constexpr (!Epi::AFTER_DRAIN) { E(acc, cur, wr, wc, fr, fq, lds, tid, ui, nxt, has_next); S.done(cur); }
        if (!has_next) break;
#pragma unroll
        for (int a = 0; a < 2; ++a)
#pragma unroll
            for (int b = 0; b < 2; ++b)
#pragma unroll
                for (int m = 0; m < 4; ++m)
#pragma unroll
                    for (int n = 0; n < 2; ++n) acc[a][b][m][n] = (f32x4){0.f, 0.f, 0.f, 0.f};
        cur = nxt; cA = nA; cB = nB; ++ui;
        if constexpr (ALIGN_EPI) { if (wr == 1) PG8_BAR; }
    }
    PG8_WAIT_V(0);
    if constexpr (!ALIGN_EPI) { if (wr == 0) PG8_BAR; }
    PG8_BAR;
    if constexpr (Epi::AFTER_DRAIN) { E.fused(acc, cur, wr, wc, fr, fq, lds, wid, lane); S.done(cur); }
#undef PG8_SA
#undef PG8_SB
#undef PG8_STAGE
#undef PG8_LDA
#undef PG8_LDB
#undef PG8_MMA
#undef PG8_WAIT_V
#undef PG8_WAIT_L
#undef PG8_BAR
#undef PG8_SCHED
}
}

namespace mk {
using pg8::bf16_t; using pg8::bf16x8; using pg8::f32x4; using pg8::u32x4; using pg8::Unit; using pg8::cvt_pk_bf16;
#define LAS __attribute__((address_space(3)))
typedef float f32x16 __attribute__((ext_vector_type(16)));
typedef short v4i16_t __attribute__((ext_vector_type(4)));
#define XB_TMO      128
#define XB_XCNT(j)  (256  + 64 * (j))
#define XB_XSUB(j)  (1280 + 64 * (j))
#define XB_XGEN(j)  (2304 + 64 * (j))
#define XB_TOP      3328
#define XB_TOPGEN   3392
#define XCD_BAR_WORDS 3456
#define XB_SPIN_CAP (1u << 18)

__device__ __forceinline__ unsigned xb_ld(unsigned* p)              { return __hip_atomic_load(p, __ATOMIC_RELAXED, __HIP_MEMORY_SCOPE_AGENT); }
__device__ __forceinline__ unsigned xb_add(unsigned* p, unsigned v) { return __hip_atomic_fetch_add(p, v, __ATOMIC_RELAXED, __HIP_MEMORY_SCOPE_AGENT); }
__device__ __forceinline__ unsigned xb_xcc_id() { return (unsigned)__builtin_amdgcn_s_getreg((3 << 11) | 20) & 0xFu; }
#define XB_SPIN(cond, bar) do { unsigned _sp = 0; while (cond) { __builtin_amdgcn_s_sleep(1); \
    if ((++_sp & 255u) == 0u) { if (xb_ld(&(bar)[XB_TMO])) break; if (_sp > XB_SPIN_CAP) { atomicAdd(&(bar)[XB_TMO], 1u); break; } } } } while (0)

struct XcdBarrier {
    unsigned* bar; unsigned x;
    volatile LAS unsigned* st;
};

__device__ __forceinline__ XcdBarrier xcd_barrier_post(unsigned* bar, volatile LAS unsigned* st) {
    XcdBarrier b; b.bar = bar; b.x = xb_xcc_id(); b.st = st;
    if (threadIdx.x == 0) (void)xb_add(&bar[XB_XCNT(b.x)], 1u);
    return b;
}
__device__ __forceinline__ void xcd_barrier_complete(unsigned* bar, unsigned x, unsigned& nloc, unsigned& nx) {
    const unsigned G = gridDim.x * gridDim.y * gridDim.z;
    unsigned sum, cnt, mine, sp = 0u;
    for (;;) {
        sum = 0u; cnt = 0u; mine = 0u;
#pragma unroll
        for (unsigned j = 0; j < 16; ++j) { const unsigned c = xb_ld(&bar[XB_XCNT(j)]); sum += c; cnt += (c > 0u) ? 1u : 0u; mine = (j == x) ? c : mine; }
        if (sum == G) break;
        __builtin_amdgcn_s_sleep(1);
        if ((++sp & 255u) == 0u) { if (xb_ld(&bar[XB_TMO])) break; if (sp > XB_SPIN_CAP) { atomicAdd(&bar[XB_TMO], 1u); break; } }
    }
    nloc = mine > 0u ? mine : 1u; nx = cnt > 0u ? cnt : 1u;
}

__device__ __forceinline__ void xcd_barrier(const XcdBarrier& b) {
    asm volatile("s_waitcnt vmcnt(0)" ::: "memory");
    __syncthreads();
    if (threadIdx.x == 0) {
        unsigned* bar = b.bar;
        __builtin_amdgcn_s_waitcnt(0);
        unsigned nloc = b.st[0], nx = b.st[1];
        if (nloc == 0u) { xcd_barrier_complete(bar, b.x, nloc, nx); b.st[0] = nloc; b.st[1] = nx; }
        const unsigned old = xb_add(&bar[XB_XSUB(b.x)], 1u);
        const unsigned gen = old / nloc;
        if (old + 1u == (gen + 1u) * nloc) {
            __builtin_amdgcn_fence(__ATOMIC_RELEASE, "agent");
            asm volatile("s_waitcnt vmcnt(0)" ::: "memory");
            const unsigned og = xb_add(&bar[XB_TOP], 1u);
            const unsigned tg = og / nx;
            if (og + 1u == (tg + 1u) * nx) xb_add(&bar[XB_TOPGEN], 1u);
            else XB_SPIN(xb_ld(&bar[XB_TOPGEN]) == tg, bar);
            __builtin_amdgcn_fence(__ATOMIC_ACQUIRE, "agent");
            xb_add(&bar[XB_XGEN(b.x)], 1u);
            asm volatile("s_waitcnt vmcnt(0)" ::: "memory");
        } else {
            XB_SPIN(xb_ld(&bar[XB_XGEN(b.x)]) == gen, bar);
            __builtin_amdgcn_fence(__ATOMIC_ACQUIRE, "agent");
            asm volatile("s_waitcnt vmcnt(0)" ::: "memory");
        }
    }
    __syncthreads();
}

#define XB_LSUB(j)  (3456 + 64 * (j))
#define XB_LGEN(j)  (3968 + 64 * (j))
#define XB_ALL_WORDS 4480
__device__ __forceinline__ void xcd_local_barrier(const XcdBarrier& b) {
    asm volatile("s_waitcnt vmcnt(0)" ::: "memory");
    __syncthreads();
    if (threadIdx.x == 0) {
        unsigned* bar = b.bar;
        __builtin_amdgcn_s_waitcnt(0);
        const unsigned nloc = b.st[0];
        const unsigned old = xb_add(&bar[XB_LSUB(b.x)], 1u);
        const unsigned gen = old / nloc;
        if (old + 1u == (gen + 1u) * nloc) xb_add(&bar[XB_LGEN(b.x)], 1u);
        else XB_SPIN(xb_ld(&bar[XB_LGEN(b.x)]) == gen, bar);
        __builtin_amdgcn_fence(__ATOMIC_ACQUIRE, "agent");
        asm volatile("s_waitcnt vmcnt(0)" ::: "memory");
    }
    __syncthreads();
}

constexpr int M = 32768, D = 1024, FF = 2816, SEQ = 4096, NB = 8, NH = 16, HD = 64, CW = 31;
constexpr float RMS_EPS = 1e-6f, LN_EPS = 1e-5f, LOG2E = 1.4426950408889634f;
constexpr int NWAVES = 8, NTHREADS = 512;
constexpr int LDS_BYTES = 147456;

constexpr size_t MiB = 1u << 20;
constexpr size_t WS_SSP = 0;
constexpr size_t SSP_STRIDE = (size_t)M * 16;
constexpr size_t WS_BAR = 15 * MiB;
constexpr size_t WS_WIN = 16 * MiB;
constexpr size_t WIN_STRIDE = (size_t)2 * FF * D;
constexpr size_t WS_WOUT = WS_WIN + 4 * WIN_STRIDE * 2;
constexpr size_t WOUT_STRIDE = (size_t)D * FF;
constexpr size_t WS_WPW1 = WS_WOUT + 4 * WOUT_STRIDE * 2;
constexpr size_t WS_WPW2 = WS_WPW1 + (size_t)2 * D * D * 2;
constexpr size_t WS_WQKV = WS_WPW2 + (size_t)D * D * 2;
constexpr size_t WS_WO = WS_WQKV + (size_t)3 * D * D * 2;
constexpr size_t WS_XB = 98 * MiB;
constexpr size_t WS_R = 162 * MiB;
constexpr size_t WS_O = 354 * MiB;
constexpr size_t WS_END = 418 * MiB;
static_assert(WS_WO + (size_t)D * D * 2 <= WS_XB, "ws map");
static_assert((size_t)M * FF * 2 <= 192 * MiB, "ws map");

__device__ __forceinline__ float sigm(float x) { return __builtin_amdgcn_rcpf(1.f + __builtin_amdgcn_exp2f(-LOG2E * x)); }
__device__ __forceinline__ float wave_sum(float v) {
#pragma unroll
    for (int o = 1; o < 64; o <<= 1) v += __shfl_xor(v, o);
    return v;
}
__device__ __forceinline__ float row_rstd(const float* ssp, int row) {
    const f32x4* p = (const f32x4*)(ssp + (size_t)row * 16);
    f32x4 a = p[0], b = p[1], c = p[2], d = p[3]; a = (a + b) + (c + d);
    return rsqrtf(((a.x + a.y) + (a.z + a.w)) * (1.f / D) + RMS_EPS);
}

constexpr int RS_LDS_OFF = 131072;
__device__ __forceinline__ void rs_issue(const float* ssp, const Unit& u, int tid, f32x4& a, f32x4& b) { const float* p = ssp + (size_t)(u.pm * 256 + (tid >> 1)) * 16 + 8 * (tid & 1); a = *(const f32x4*)p; b = *(const f32x4*)(p + 4); }
__device__ __forceinline__ void rs_finish(LAS unsigned char* lds, int buf, int tid, const f32x4& a, const f32x4& b) {
    float t = ((a.x + a.y) + (a.z + a.w)) + ((b.x + b.y) + (b.z + b.w)); t += __shfl_xor(t, 1);
    if (!(tid & 1)) ((LAS float*)(lds + RS_LDS_OFF))[buf * 256 + (tid >> 1)] = rsqrtf(t * (1.f / D) + RMS_EPS);
}
__device__ __forceinline__ void rs_read(LAS unsigned char* lds, int buf, int wr, int fr, float (&rs)[2][4]) {
    const LAS float* t = (const LAS float*)(lds + RS_LDS_OFF) + buf * 256 + wr * 64 + fr;
#pragma unroll
    for (int ai = 0; ai < 2; ++ai)
#pragma unroll
        for (int m = 0; m < 4; ++m) rs[ai][m] = t[ai * 128 + m * 16];
}
struct EpiSwiGLU {
    static constexpr bool PERM = true, AFTER_DRAIN = false; static constexpr int NST = 8;
    bf16_t* O; const float* ssp;
    __device__ __forceinline__ void rs_first(const Unit& u, LAS unsigned char* lds, int tid) const { f32x4 a, b; rs_issue(ssp, u, tid, a, b); rs_finish(lds, 0, tid, a, b); }
    __device__ __forceinline__ void operator()(const f32x4 (&acc)[2][2][4][2], const Unit& u, int wr, int wc, int fr, int fq, LAS unsigned char* lds, int tid, int ui, const Unit& nxt, bool has_next) const {
        f32x4 na, nb; if (has_next) rs_issue(ssp, nxt, tid, na, nb);
        const int row0 = u.pm * 256 + wr * 64 + fr, col0 = u.pn * 128 + wc * 32 + 8 * fq;
        float rsv[2][4]; rs_read(lds, ui & 1, wr, fr, rsv);
#pragma unroll
        for (int ai = 0; ai < 2; ++ai)
#pragma unroll
            for (int m = 0; m < 4; ++m) {
                const int row = row0 + ai * 128 + m * 16;
                const float rs = rsv[ai][m];
                typedef float f32x2 __attribute__((ext_vector_type(2)));
                const f32x2 rs2 = (f32x2){rs, rs}, nrs2 = (f32x2){-LOG2E * rs, -LOG2E * rs};
                unsigned wv[4];
#pragma unroll
                for (int n = 0; n < 2; ++n)
#pragma unroll
                    for (int hp = 0; hp < 2; ++hp) {
                        const f32x2 ag = (f32x2){acc[ai][0][m][n][2 * hp], acc[ai][0][m][n][2 * hp + 1]}, au = (f32x2){acc[ai][1][m][n][2 * hp], acc[ai][1][m][n][2 * hp + 1]};
                        const f32x2 g = ag * rs2, up = au * rs2, ne = ag * nrs2;
                        const f32x2 dd = (f32x2){__builtin_amdgcn_exp2f(ne.x), __builtin_amdgcn_exp2f(ne.y)} + 1.0f;
                        const f32x2 rr = (f32x2){__builtin_amdgcn_rcpf(dd.x), __builtin_amdgcn_rcpf(dd.y)};
                        const f32x2 oo = (g * rr) * up;
                        wv[n * 2 + hp] = cvt_pk_bf16(oo.x, oo.y);
                    }
                u32x4 w; w.x = wv[0]; w.y = wv[1]; w.z = wv[2]; w.w = wv[3];
                __builtin_nontemporal_store(w, (u32x4*)(O + (size_t)row * FF + col0));
            }
        if (has_next) rs_finish(lds, (ui + 1) & 1, tid, na, nb);
    }
};
struct EpiGLU {
    static constexpr bool PERM = true, AFTER_DRAIN = false; static constexpr int NST = 8;
    bf16_t* O; const float* ssp; const float* bias;
    __device__ __forceinline__ void rs_first(const Unit& u, LAS unsigned char* lds, int tid) const { f32x4 a, b; rs_issue(ssp, u, tid, a, b); rs_finish(lds, 0, tid, a, b); }
    __device__ __forceinline__ void operator()(const f32x4 (&acc)[2][2][4][2], const Unit& u, int wr, int wc, int fr, int fq, LAS unsigned char* lds, int tid, int ui, const Unit& nxt, bool has_next) const {
        f32x4 na, nb; if (has_next) rs_issue(ssp, nxt, tid, na, nb);
        const int row0 = u.pm * 256 + wr * 64 + fr, col0 = u.pn * 128 + wc * 32 + 8 * fq;
        f32x4 bv[2][2];
#pragma unroll
        for (int bj = 0; bj < 2; ++bj)
#pragma unroll
            for (int n = 0; n < 2; ++n) bv[bj][n] = *(const f32x4*)(bias + bj * D + col0 + 4 * n);
        float rsv[2][4]; rs_read(lds, ui & 1, wr, fr, rsv);
#pragma unroll
        for (int ai = 0; ai < 2; ++ai)
#pragma unroll
            for (int m = 0; m < 4; ++m) {
                const int row = row0 + ai * 128 + m * 16;
                const float rs = rsv[ai][m];
                float o[8];
#pragma unroll
                for (int n = 0; n < 2; ++n)
#pragma unroll
                    for (int e = 0; e < 4; ++e) { const float v = acc[ai][0][m][n][e] * rs + bv[0][n][e], g = acc[ai][1][m][n][e] * rs + bv[1][n][e]; o[n * 4 + e] = v * sigm(g); }
                u32x4 w; w.x = cvt_pk_bf16(o[0], o[1]); w.y = cvt_pk_bf16(o[2], o[3]); w.z = cvt_pk_bf16(o[4], o[5]); w.w = cvt_pk_bf16(o[6], o[7]);
                *(u32x4*)(O + (size_t)row * D + col0) = w;
            }
        if (has_next) rs_finish(lds, (ui + 1) & 1, tid, na, nb);
    }
};
struct EpiQKV {
    static constexpr bool PERM = true, AFTER_DRAIN = false; static constexpr int NST = 16;
    bf16_t* O; const float* ssp; size_t tstride;
    __device__ __forceinline__ void rs_first(const Unit& u, LAS unsigned char* lds, int tid) const { f32x4 a, b; rs_issue(ssp, u, tid, a, b); rs_finish(lds, 0, tid, a, b); }
    __device__ __forceinline__ void operator()(const f32x4 (&acc)[2][2][4][2], const Unit& u, int wr, int wc, int fr, int fq, LAS unsigned char* lds, int tid, int ui, const Unit& nxt, bool has_next) const {
        f32x4 na, nb; if (has_next) rs_issue(ssp, nxt, tid, na, nb);
        const int row0 = u.pm * 256 + wr * 64 + fr; const int t = u.pn >> 2;
        bf16_t* base = O + (size_t)t * tstride; const int col0 = (u.pn & 3) * 256 + wc * 32 + 8 * fq;
        float rsv[2][4]; rs_read(lds, ui & 1, wr, fr, rsv);
#pragma unroll
        for (int ai = 0; ai < 2; ++ai)
#pragma unroll
            for (int m = 0; m < 4; ++m) {
                const int row = row0 + ai * 128 + m * 16;
                const float rs = rsv[ai][m];
#pragma unroll
                for (int bj = 0; bj < 2; ++bj) {
                    const f32x4 v0 = acc[ai][bj][m][0] * rs, v1 = acc[ai][bj][m][1] * rs;
                    u32x4 w; w.x = cvt_pk_bf16(v0[0], v0[1]); w.y = cvt_pk_bf16(v0[2], v0[3]); w.z = cvt_pk_bf16(v1[0], v1[1]); w.w = cvt_pk_bf16(v1[2], v1[3]);
                    *(u32x4*)(base + (size_t)row * D + col0 + bj * 128) = w;
                }
            }
        if (has_next) rs_finish(lds, (ui + 1) & 1, tid, na, nb);
    }
};
struct EpiResid {
    static constexpr bool PERM = true, AFTER_DRAIN = false; static constexpr int NST = 24;
    bf16_t* xb; float* ssp; const float* bias; float alpha;
    __device__ __forceinline__ void rs_first(const Unit&, LAS unsigned char*, int) const {}
    __device__ __forceinline__ void operator()(const f32x4 (&acc)[2][2][4][2], const Unit& u, int wr, int wc, int fr, int fq, LAS unsigned char* lds, int tid, int ui, const Unit& nxt, bool has_next) const {
        const int row0 = u.pm * 256 + wr * 64 + fr, col0 = u.pn * 256 + wc * 32 + 8 * fq;
        f32x4 bv[2][2];
#pragma unroll
        for (int bj = 0; bj < 2; ++bj)
#pragma unroll
            for (int n = 0; n < 2; ++n) bv[bj][n] = bias ? *(const f32x4*)(bias + col0 + bj * 128 + 4 * n) : (f32x4){0.f, 0.f, 0.f, 0.f};
#pragma unroll
        for (int ai = 0; ai < 2; ++ai) {
            u32x4 xr[4][2];
#pragma unroll
            for (int m = 0; m < 4; ++m)
#pragma unroll
                for (int bj = 0; bj < 2; ++bj) xr[m][bj] = *(const u32x4*)(xb + (size_t)(row0 + ai * 128 + m * 16) * D + col0 + bj * 128);
#pragma unroll
            for (int m = 0; m < 4; ++m) {
                const int row = row0 + ai * 128 + m * 16; const size_t off = (size_t)row * D + col0;
                typedef float f32x2 __attribute__((ext_vector_type(2)));
                f32x2 sq2 = (f32x2){0.f, 0.f};
#pragma unroll
                for (int bj = 0; bj < 2; ++bj) {
                    f32x2 v[4];
                    const u32x4 w0 = xr[m][bj];
#pragma unroll
                    for (int i = 0; i < 4; ++i) v[i] = (f32x2){__uint_as_float(w0[i] << 16), __uint_as_float(w0[i] & 0xffff0000u)};
                    const f32x2 al2 = (f32x2){alpha, alpha};
                    unsigned wv[4];
#pragma unroll
                    for (int i = 0; i < 4; ++i) {
                        const f32x4 av = acc[ai][bj][m][i >> 1], bb = bv[bj][i >> 1];
                        const f32x2 a2 = (i & 1) ? (f32x2){av.z, av.w} : (f32x2){av.x, av.y}, b2 = (i & 1) ? (f32x2){bb.z, bb.w} : (f32x2){bb.x, bb.y};
                        v[i] = __builtin_elementwise_fma(a2, al2, v[i]) + b2;
                        sq2 = __builtin_elementwise_fma(v[i], v[i], sq2);
                        wv[i] = cvt_pk_bf16(v[i].x, v[i].y);
                    }
                    u32x4 w; w.x = wv[0]; w.y = wv[1]; w.z = wv[2]; w.w = wv[3];
                    *(u32x4*)(xb + off + bj * 128) = w;
                }
                float sq = sq2.x + sq2.y;
                sq += __shfl_xor(sq, 16); sq += __shfl_xor(sq, 32);
                if (fq == 0) ssp[(size_t)row * 16 + u.pn * 4 + wc] = sq;
            }
            asm volatile("" ::: "memory");
        }
    }
};

__device__ __forceinline__ void transpose_item(const float* W, int K, int N, const float* g, bf16_t* WT, int glu_h, LAS float* scr, int item, int lane) {
    const int nblk = N / 64, kb = item / nblk, nb = item % nblk, k0 = 64 * kb, n0 = 64 * nb;
    const int lr = lane >> 4, c4 = lane & 15;
    f32x4 v[16];
#pragma unroll
    for (int i = 0; i < 16; ++i) v[i] = __builtin_nontemporal_load((const f32x4*)(W + (size_t)(k0 + 4 * i + lr) * N + n0 + 4 * c4));
    if (g) {
#pragma unroll
        for (int i = 0; i < 16; ++i) v[i] = v[i] * g[k0 + 4 * i + lr];
    }
#pragma unroll
    for (int i = 0; i < 16; ++i) { LAS float* d = scr + (4 * i + lr) * 65 + 4 * c4; d[0] = v[i].x; d[1] = v[i].y; d[2] = v[i].z; d[3] = v[i].w; }
    asm volatile("s_waitcnt lgkmcnt(0)" ::: "memory");
    int drow0 = n0;
    if (glu_h) { const int up = n0 >= glu_h, c = up ? n0 - glu_h : n0; drow0 = (c >> 7) * 256 + up * 128 + (c & 127); }
    const int c = lane & 7;
#pragma unroll
    for (int j = 0; j < 8; ++j) { const int n = (lane >> 3) + 8 * j; const LAS float* p = scr + (8 * c) * 65 + n;
        u32x4 o; o.x = cvt_pk_bf16(p[0 * 65], p[1 * 65]); o.y = cvt_pk_bf16(p[2 * 65], p[3 * 65]); o.z = cvt_pk_bf16(p[4 * 65], p[5 * 65]); o.w = cvt_pk_bf16(p[6 * 65], p[7 * 65]);
        *(u32x4*)(WT + (size_t)(drow0 + n) * K + k0 + 8 * c) = o; }
    asm volatile("s_waitcnt lgkmcnt(0)" ::: "memory");
}

struct Ptrs {
    const float *x, *norm_g, *final_g, *ffn_w_in, *ffn_w_out, *w_pw1, *b_pw1, *w_dw, *b_dw, *ln_g, *ln_b, *w_pw2, *b_pw2, *w_qkv, *w_o;
    float* out; unsigned char* ws;
};

__device__ __forceinline__ void prologue(const Ptrs& P, LAS unsigned char* lds, int vcu, int G, int wave, int lane) {
    LAS float* scr = (LAS float*)(lds + wave * 18432);
    const int gw = vcu * NWAVES + wave, NGW = G * NWAVES;
    constexpr int I_IN = (D / 64) * (2 * FF / 64), I_OUT = (FF / 64) * (D / 64), I_PW1 = (D / 64) * (2 * D / 64), I_SQ = (D / 64) * (D / 64), I_QKV = (D / 64) * (3 * D / 64);
    constexpr int NITEMS = 4 * I_IN + 4 * I_OUT + I_PW1 + I_SQ + I_QKV + I_SQ;
    bf16_t* ws16 = (bf16_t*)P.ws;
    for (int it = gw; it < NITEMS; it += NGW) {
        int r = it; const float* W; const float* g = nullptr; bf16_t* WT; int K = D, N = D, glu = 0;
        if (r < 4 * I_IN) { const int idx = r / I_IN, l = idx >> 1, j = idx & 1; r -= idx * I_IN;
            W = P.ffn_w_in + (size_t)idx * D * 2 * FF; N = 2 * FF; g = P.norm_g + (l * 3 + (j ? 2 : 0)) * D; WT = (bf16_t*)(P.ws + WS_WIN) + idx * WIN_STRIDE; glu = FF; }
        else if ((r -= 4 * I_IN) < 4 * I_OUT) { const int idx = r / I_OUT; r -= idx * I_OUT;
            W = P.ffn_w_out + (size_t)idx * FF * D; K = FF; WT = (bf16_t*)(P.ws + WS_WOUT) + idx * WOUT_STRIDE; }
        else if ((r -= 4 * I_OUT) < I_PW1) { W = P.w_pw1; N = 2 * D; g = P.norm_g + 1 * D; WT = (bf16_t*)(P.ws + WS_WPW1); glu = D; }
        else if ((r -= I_PW1) < I_SQ) { W = P.w_pw2; WT = (bf16_t*)(P.ws + WS_WPW2); }
        else if ((r -= I_SQ) < I_QKV) { W = P.w_qkv; N = 3 * D; g = P.norm_g + 4 * D; WT = (bf16_t*)(P.ws + WS_WQKV); }
        else { r -= I_QKV; W = P.w_o; WT = (bf16_t*)(P.ws + WS_WO); }
        transpose_item(W, K, N, g, WT, glu, scr, r, lane);
    }
    (void)ws16;
    bf16_t* xb = (bf16_t*)(P.ws + WS_XB); float* ssp0 = (float*)(P.ws + WS_SSP);
    for (int m0 = gw; m0 < M; m0 += 2 * NGW) {
        f32x4 v[2][4]; float sq[2];
#pragma unroll
        for (int t = 0; t < 2; ++t) { const f32x4* xr = (const f32x4*)(P.x + (size_t)((t && m0 + NGW >= M) ? m0 : m0 + t * NGW) * D) + lane;
#pragma unroll
            for (int j = 0; j < 4; ++j) v[t][j] = __builtin_nontemporal_load(xr + 64 * j); }
#pragma unroll
        for (int t = 0; t < 2; ++t) { float s_ = 0.f;
#pragma unroll
            for (int j = 0; j < 4; ++j) s_ += (v[t][j].x * v[t][j].x + v[t][j].y * v[t][j].y) + (v[t][j].z * v[t][j].z + v[t][j].w * v[t][j].w);
            sq[t] = wave_sum(s_); }
#pragma unroll
        for (int t = 0; t < 2; ++t) { const int m = (t && m0 + NGW >= M) ? m0 : m0 + t * NGW;
            unsigned long long* o8 = (unsigned long long*)(xb + (size_t)m * D) + lane;
#pragma unroll
            for (int j = 0; j < 4; ++j) o8[64 * j] = (unsigned long long)cvt_pk_bf16(v[t][j].x, v[t][j].y) | ((unsigned long long)cvt_pk_bf16(v[t][j].z, v[t][j].w) << 32);
            if (lane < 16) ssp0[(size_t)m * 16 + lane] = lane == 0 ? sq[t] : 0.f; }
    }
}

__device__ __forceinline__ void conv_phase(LAS unsigned char* lds, const bf16_t* U, bf16_t* C, const float* wdw, const float* bdw, const float* lng, const float* lnb,
                                           int first, int stride, int end, int tid, int wave, int lane) {
    constexpr int TT = 32, ROWS = TT + CW - 1;
    for (int tile = first; tile < end; tile += stride) {
        const int t0 = tile * TT, tin = t0 % SEQ;
        for (int idx = tid; idx < ROWS * 128; idx += NTHREADS) {
            const int row = idx >> 7, ch = idx & 127;
            u32x4 v = (u32x4){0u, 0u, 0u, 0u};
            if (tin + row - (CW - 1) >= 0) v = *(const u32x4*)(U + (size_t)(t0 + row - (CW - 1)) * D + ch * 8);
            *(LAS u32x4*)(lds + row * 2048 + ch * 16) = v;
        }
        asm volatile("s_waitcnt lgkmcnt(0)" ::: "memory"); __builtin_amdgcn_s_barrier(); asm volatile("" ::: "memory");
        typedef float f32x2 __attribute__((ext_vector_type(2)));
        f32x2 acc[2][4][4];
#pragma unroll
        for (int p = 0; p < 2; ++p) {
#pragma unroll
            for (int j = 0; j < 4; ++j)
#pragma unroll
                for (int c = 0; c < 4; ++c) acc[p][j][c] = (f32x2){0.f, 0.f};
            f32x4 wt[8][2];
            const float* wq = wdw + p * 512 + lane * 8;
#pragma unroll
            for (int t = 0; t < 4; ++t) { wt[t][0] = *(const f32x4*)(wq); wt[t][1] = *(const f32x4*)(wq + 4); wq += D; asm volatile("" : "+v"(wq)); }
#pragma unroll
            for (int r = 0; r < TT / NWAVES + CW - 1; ++r) {
                if (r + 4 < CW) { wt[(r + 4) & 7][0] = *(const f32x4*)(wq); wt[(r + 4) & 7][1] = *(const f32x4*)(wq + 4); wq += D; asm volatile("" : "+v"(wq)); }
                const u32x4 xv = *(const LAS u32x4*)(lds + (4 * wave + r) * 2048 + p * 1024 + lane * 16);
                f32x2 x[4];
#pragma unroll
                for (int i = 0; i < 4; ++i) x[i] = (f32x2){__uint_as_float(xv[i] << 16), __uint_as_float(xv[i] & 0xffff0000u)};
#pragma unroll
                for (int j = 0; j < 4; ++j) { const int w = r - j;
                    if (w >= 0 && w < CW) {
#pragma unroll
                        for (int c = 0; c < 4; ++c) { const f32x4 wv = wt[w & 7][c >> 1]; const f32x2 w2 = (c & 1) ? (f32x2){wv.z, wv.w} : (f32x2){wv.x, wv.y}; acc[p][j][c] = __builtin_elementwise_fma(w2, x[c], acc[p][j][c]); } } }
                asm volatile("" ::: "memory");
            }
            const f32x4 b0 = *(const f32x4*)(bdw + p * 512 + lane * 8), b1 = *(const f32x4*)(bdw + p * 512 + lane * 8 + 4);
#pragma unroll
            for (int j = 0; j < 4; ++j) { acc[p][j][0] += (f32x2){b0.x, b0.y}; acc[p][j][1] += (f32x2){b0.z, b0.w}; acc[p][j][2] += (f32x2){b1.x, b1.y}; acc[p][j][3] += (f32x2){b1.z, b1.w}; }
        }
        float mean[4], rstd[4];
#pragma unroll
        for (int j = 0; j < 4; ++j) { f32x2 s2 = (f32x2){0.f, 0.f};
#pragma unroll
            for (int p = 0; p < 2; ++p)
#pragma unroll
                for (int c = 0; c < 4; ++c) s2 += acc[p][j][c];
            mean[j] = wave_sum(s2.x + s2.y) * (1.f / D); f32x2 q2 = (f32x2){0.f, 0.f};
#pragma unroll
            for (int p = 0; p < 2; ++p)
#pragma unroll
                for (int c = 0; c < 4; ++c) { const f32x2 d = acc[p][j][c] - mean[j]; q2 += d * d; }
            rstd[j] = rsqrtf(wave_sum(q2.x + q2.y) * (1.f / D) + LN_EPS); }
#pragma unroll
        for (int p = 0; p < 2; ++p) {
            const f32x4 g0 = *(const f32x4*)(lng + p * 512 + lane * 8), g1 = *(const f32x4*)(lng + p * 512 + lane * 8 + 4);
            const f32x4 c0 = *(const f32x4*)(lnb + p * 512 + lane * 8), c1 = *(const f32x4*)(lnb + p * 512 + lane * 8 + 4);
            const float gg[8] = {g0.x, g0.y, g0.z, g0.w, g1.x, g1.y, g1.z, g1.w}, bb[8] = {c0.x, c0.y, c0.z, c0.w, c1.x, c1.y, c1.z, c1.w};
#pragma unroll
            for (int j = 0; j < 4; ++j) { float o[8];
#pragma unroll
                for (int c = 0; c < 8; ++c) { const float y = (acc[p][j][c >> 1][c & 1] - mean[j]) * rstd[j] * gg[c] + bb[c]; o[c] = y * sigm(y); }
                u32x4 w; w.x = cvt_pk_bf16(o[0], o[1]); w.y = cvt_pk_bf16(o[2], o[3]); w.z = cvt_pk_bf16(o[4], o[5]); w.w = cvt_pk_bf16(o[6], o[7]);
                *(u32x4*)(C + (size_t)(t0 + 4 * wave + j) * D + p * 512 + lane * 8) = w; }
        }
        asm volatile("s_waitcnt lgkmcnt(0)" ::: "memory"); __builtin_amdgcn_s_barrier(); asm volatile("" ::: "memory");
    }
}

__device__ __forceinline__ void attn_phase(LAS unsigned char* lds, const bf16_t* Q, const bf16_t* Kp, const bf16_t* Vp, bf16_t* O, int first, int stride, int end, int wave, int lane) {
    const int r32 = lane & 31, hi = lane >> 5;
    LAS unsigned char* vl = lds + wave * 8704;
    LAS unsigned char* kl = vl + 4096;
    const int trb = (4 * hi + ((lane & 15) >> 2)) * 128 + ((lane >> 4) & 1) * 32 + (lane & 3) * 8;
    for (int u = first + wave; u < end; u += stride) {
        const int bh = u >> 7, qblk = u & 127, b = bh >> 4, h = bh & 15;
        const size_t rowbase = (size_t)b * SEQ;
        const bf16_t* Qw = Q + (rowbase + qblk * 32 + r32) * D + h * HD + hi * 8;
        bf16x8 qr[4];
#pragma unroll
        for (int d0 = 0; d0 < 4; ++d0) qr[d0] = *(const bf16x8*)(Qw + d0 * 16);
        const bf16_t* Kl = Kp + (rowbase + (lane >> 3)) * D + h * HD + (lane & 7) * 8;
        const bf16_t* Vl = Vp + (rowbase + (lane >> 3)) * D + h * HD + (lane & 7) * 8;
        u32x4 kn[4]; u32x4 vn[4];
#pragma unroll
        for (int i = 0; i < 4; ++i) { kn[i] = *(const u32x4*)(Kl + (size_t)(qblk * 32 + 8 * i) * D); vn[i] = *(const u32x4*)(Vl + (size_t)(qblk * 32 + 8 * i) * D); }
        f32x16 o0 = {}, o1 = {}; float carry = 1.f;
        for (int kt = qblk; kt >= 0; --kt) {
#pragma unroll
            for (int i = 0; i < 4; ++i) { *(LAS u32x4*)(vl + ((lane >> 3) + 8 * i) * 128 + (lane & 7) * 16) = vn[i]; *(LAS u32x4*)(kl + ((lane >> 3) + 8 * i) * 144 + (lane & 7) * 16) = kn[i]; }
            bf16x8 kc[4];
#pragma unroll
            for (int i = 0; i < 4; ++i) kc[i] = *(const LAS bf16x8*)(kl + r32 * 144 + i * 32 + hi * 16);
            if (kt > 0) {
#pragma unroll
                for (int i = 0; i < 4; ++i) { kn[i] = *(const u32x4*)(Kl + (size_t)((kt - 1) * 32 + 8 * i) * D); vn[i] = *(const u32x4*)(Vl + (size_t)((kt - 1) * 32 + 8 * i) * D); }
            }
            f32x16 p = {};
#pragma unroll
            for (int d0 = 0; d0 < 4; ++d0) p = __builtin_amdgcn_mfma_f32_32x32x16_bf16(kc[d0], qr[d0], p, 0, 0, 0);
            const bool diag = (kt == qblk);
            float beta[16], om[16];
#pragma unroll
            for (int r = 0; r < 16; ++r) {
                const float z = p[r] * 0.125f, e = __builtin_amdgcn_exp2f(-LOG2E * __builtin_fabsf(z)), rc = __builtin_amdgcn_rcpf(1.f + e), sm = e * rc;
                const bool pos = z >= 0.f; float bt = pos ? rc : sm, o_ = pos ? sm : rc;
                const int kvl = (r & 3) + 8 * (r >> 2) + 4 * hi;
                if (diag && kvl >= r32) { bt = 0.f; o_ = 1.f; }
                beta[r] = bt; om[r] = o_;
            }
            float Gm[4], Gp[4];
#pragma unroll
            for (int g = 0; g < 4; ++g) { Gm[g] = (om[4 * g] * om[4 * g + 1]) * (om[4 * g + 2] * om[4 * g + 3]); Gp[g] = __shfl_xor(Gm[g], 32); }
            float SO[4], SP[4];
            SO[3] = 1.f; SO[2] = Gm[3]; SO[1] = SO[2] * Gm[2]; SO[0] = SO[1] * Gm[1];
            SP[3] = 1.f; SP[2] = Gp[3]; SP[1] = SP[2] * Gp[2]; SP[0] = SP[1] * Gp[1];
            float A[16];
#pragma unroll
            for (int g = 0; g < 4; ++g) {
                const float E = carry * SO[g] * (hi ? SP[g] : SP[g] * Gp[g]);
                const float P3 = E, P2 = P3 * om[4 * g + 3], P1 = P2 * om[4 * g + 2], P0 = P1 * om[4 * g + 1];
                A[4 * g + 3] = beta[4 * g + 3] * P3; A[4 * g + 2] = beta[4 * g + 2] * P2; A[4 * g + 1] = beta[4 * g + 1] * P1; A[4 * g] = beta[4 * g] * P0;
            }
            carry = carry * (SO[0] * Gm[0]) * (SP[0] * Gp[0]);
            u32x4 pw0, pw1;
            pw0.x = cvt_pk_bf16(A[0], A[1]); pw0.y = cvt_pk_bf16(A[2], A[3]); pw0.z = cvt_pk_bf16(A[4], A[5]); pw0.w = cvt_pk_bf16(A[6], A[7]);
            pw1.x = cvt_pk_bf16(A[8], A[9]); pw1.y = cvt_pk_bf16(A[10], A[11]); pw1.z = cvt_pk_bf16(A[12], A[13]); pw1.w = cvt_pk_bf16(A[14], A[15]);
            const bf16x8 pa0 = __builtin_bit_cast(bf16x8, pw0), pa1 = __builtin_bit_cast(bf16x8, pw1);
            asm volatile("s_waitcnt lgkmcnt(0)" ::: "memory");
#pragma unroll
            for (int s = 0; s < 2; ++s)
#pragma unroll
                for (int d0 = 0; d0 < 2; ++d0) {
                    const v4i16_t lo = __builtin_amdgcn_ds_read_tr16_b64_v4i16((LAS v4i16_t*)(vl + trb + s * 2048 + d0 * 64));
                    const v4i16_t hh = __builtin_amdgcn_ds_read_tr16_b64_v4i16((LAS v4i16_t*)(vl + trb + s * 2048 + 1024 + d0 * 64));
                    const bf16x8 vf = (bf16x8){lo[0], lo[1], lo[2], lo[3], hh[0], hh[1], hh[2], hh[3]};
                    if (d0 == 0) o0 = __builtin_amdgcn_mfma_f32_32x32x16_bf16(s ? pa1 : pa0, vf, o0, 0, 0, 0);
                    else         o1 = __builtin_amdgcn_mfma_f32_32x32x16_bf16(s ? pa1 : pa0, vf, o1, 0, 0, 0);
                }
            asm volatile("s_waitcnt lgkmcnt(0)" ::: "memory");
            if (__builtin_amdgcn_ballot_w64(carry > 5.4210109e-20f) == 0ull) break;
        }
        bf16_t* Ow = O + (rowbase + qblk * 32) * D + h * HD + r32;
#pragma unroll
        for (int r = 0; r < 16; ++r) { const int q = (r & 3) + 8 * (r >> 2) + 4 * hi;
            const unsigned w = cvt_pk_bf16(o0[r], o1[r]);
            Ow[(size_t)q * D] = (bf16_t)(w & 0xffffu); Ow[(size_t)q * D + 32] = (bf16_t)(w >> 16); }
    }
}

struct Args { const float* in[15]; float* out; unsigned char* ws; };

__global__ void __launch_bounds__(NTHREADS, 2) mk_fwd(Args a) {
    extern __shared__ __attribute__((aligned(16))) unsigned char lds_[];
    LAS unsigned char* lds = (LAS unsigned char*)lds_;
    cg::grid_group grid = cg::this_grid();
    int tid = threadIdx.x, lane = tid & 63, wave = __builtin_amdgcn_readfirstlane(tid >> 6);
    const int G = gridDim.x, bx = blockIdx.x, vcu = (G % 8 == 0) ? (bx % 8) * (G / 8) + bx / 8 : bx;
    Ptrs P;
    P.x = a.in[0]; P.norm_g = a.in[1]; P.final_g = a.in[2]; P.ffn_w_in = a.in[3]; P.ffn_w_out = a.in[4]; P.w_pw1 = a.in[5]; P.b_pw1 = a.in[6]; P.w_dw = a.in[7]; P.b_dw = a.in[8];
    P.ln_g = a.in[9]; P.ln_b = a.in[10]; P.w_pw2 = a.in[11]; P.b_pw2 = a.in[12]; P.w_qkv = a.in[13]; P.w_o = a.in[14]; P.out = a.out; P.ws = a.ws;
    float* ssp = (float*)(P.ws + WS_SSP);
    bf16_t* Win = (bf16_t*)(P.ws + WS_WIN); bf16_t* Wout = (bf16_t*)(P.ws + WS_WOUT);
    bf16_t* Wpw1 = (bf16_t*)(P.ws + WS_WPW1); bf16_t* Wpw2 = (bf16_t*)(P.ws + WS_WPW2); bf16_t* Wqkv = (bf16_t*)(P.ws + WS_WQKV); bf16_t* Wo = (bf16_t*)(P.ws + WS_WO);
    bf16_t* xb = (bf16_t*)(P.ws + WS_XB); bf16_t* R = (bf16_t*)(P.ws + WS_R); bf16_t* Ob = (bf16_t*)(P.ws + WS_O);

    prologue(P, lds, vcu, G, wave, lane);
    unsigned* barw = (unsigned*)(P.ws + WS_BAR);
    if (bx == 0) { for (int i = threadIdx.x; i < XB_ALL_WORDS; i += NTHREADS) __hip_atomic_store(barw + i, 0u, __ATOMIC_RELAXED, __HIP_MEMORY_SCOPE_AGENT); }
    volatile LAS unsigned* bst = (volatile LAS unsigned*)(lds + LDS_BYTES - 16);
    if (threadIdx.x < 4) bst[threadIdx.x] = 0u;
    grid.sync();
    XcdBarrier bar; bar.bar = barw; bar.x = xb_xcc_id(); bar.st = bst;
    if (threadIdx.x == 0) bst[2] = xb_add(&barw[XB_XCNT(bar.x)], 1u);
    xcd_barrier(bar);
    if (threadIdx.x == 0) {
        unsigned ok = (G % 8 == 0) && (bar.x < 8u) && (bst[2] < (unsigned)(G / 8)) ? 1u : 0u;
        for (unsigned j = 0; j < 16; ++j) { const unsigned c = xb_ld(&barw[XB_XCNT(j)]); if (c != (j < 8u ? (unsigned)(G / 8) : 0u)) ok = 0u; }
        bst[3] = ok;
    }
    __syncthreads();
#pragma unroll 1
    for (int l = 0; l < 2; ++l) {
#pragma unroll 1
        for (int s = 0; s < 7; ++s) {
            tid = threadIdx.x; asm volatile("" : "+v"(tid)); lane = tid & 63; wave = __builtin_amdgcn_readfirstlane(tid >> 6);
            const bool local = bst[3] != 0u; const int xq = (int)bar.x, rank = (int)bst[2], nl = G / 8;
            const int vb = local ? xq + 8 * rank : bx;
            const size_t SLAB = (size_t)12 * 1024 * 1024, T8 = (size_t)4 * 1024 * 1024;
            bf16_t* Rx = local ? R + (size_t)xq * SLAB : R; const size_t ro = local ? (size_t)xq * SEQ : 0;
            bf16_t* act = Rx - ro * FF; bf16_t* ub = Rx - ro * D; bf16_t* cb = (local ? Rx + T8 : R + (size_t)M * D) - ro * D;
            bf16_t* qb = ub; bf16_t* kb = cb; bf16_t* vb_ = (local ? Rx + 2 * T8 : R + (size_t)2 * M * D) - ro * D;
            const size_t qkv_stride = local ? T8 : (size_t)M * D;
            if (s == 0 || s == 5) {
                const int j = s == 0 ? 0 : 1;
                pg8::Gemm g{xb, Win + (size_t)(l * 2 + j) * WIN_STRIDE, M, 2 * FF, D}; pg8::StaticOrder S; S.init(M, 2 * FF, G, vb);
                EpiSwiGLU E{act, ssp + (size_t)(3 * l + (j ? 2 : 0)) * SSP_STRIDE};
                pg8::gemm_phase<EpiSwiGLU, pg8::StaticOrder, true, true>(lds, g, S, E);
            } else if (s == 1 || s == 4 || s == 6) {
                const bf16_t* A; const bf16_t* W; int K; float alpha; const float* bias; int so;
                if (s == 4) { A = l == 0 ? cb : Ob; W = l == 0 ? Wpw2 : Wo; K = D; alpha = 1.f; bias = l == 0 ? P.b_pw2 : nullptr; so = 3 * l + 2; }
                else { const int j = s == 1 ? 0 : 1; A = act; W = Wout + (size_t)(l * 2 + j) * WOUT_STRIDE; K = FF; alpha = 0.5f; bias = nullptr; so = 3 * l + (j ? 3 : 1); }
                pg8::Gemm g{A, W, M, D, K}; pg8::StaticOrder S; S.init(M, D, G, vb);
                EpiResid E{xb, ssp + (size_t)so * SSP_STRIDE, bias, alpha};
                pg8::gemm_phase<EpiResid, pg8::StaticOrder, true, true>(lds, g, S, E);
            } else if (s == 2) {
                if (l == 0) {
                    pg8::Gemm g{xb, Wpw1, M, 2 * D, D}; pg8::StaticOrder S; S.init(M, 2 * D, G, vb);
                    EpiGLU E{ub, ssp + (size_t)1 * SSP_STRIDE, P.b_pw1};
                    pg8::gemm_phase<EpiGLU, pg8::StaticOrder, true, true>(lds, g, S, E);
                } else {
                    pg8::Gemm g{xb, Wqkv, M, 3 * D, D}; pg8::StaticOrder S; S.init(M, 3 * D, G, vb);
                    EpiQKV E{qb, ssp + (size_t)4 * SSP_STRIDE, qkv_stride};
                    pg8::gemm_phase<EpiQKV, pg8::StaticOrder, true, true>(lds, g, S, E);
                }
            } else {
                if (l == 0) conv_phase(lds, ub, cb, P.w_dw, P.b_dw, P.ln_g, P.ln_b, local ? 128 * xq + rank : vcu, local ? nl : G, local ? 128 * (xq + 1) : M / 32, tid, wave, lane);
                if (l == 1) attn_phase(lds, qb, kb, vb_, Ob, local ? xq * 2048 + rank * NWAVES : vcu * NWAVES, (local ? nl : G) * NWAVES, local ? (xq + 1) * 2048 : NB * NH * (SEQ / 32), wave, lane);
            }
            if (local) xcd_local_barrier(bar); else xcd_barrier(bar);
        }
    }
    {
        const float* ss6 = ssp + (size_t)6 * SSP_STRIDE;
        const bool local = bst[3] != 0u; const int xq = (int)bar.x, rank = (int)bst[2], nl = G / 8;
        const int fn_first = local ? xq * SEQ + rank * NWAVES : vcu * NWAVES, fn_stride = (local ? nl : G) * NWAVES, fn_end = local ? (xq + 1) * SEQ : M;
        f32x4 gv[2][2];
#pragma unroll
        for (int p = 0; p < 2; ++p) { gv[p][0] = *(const f32x4*)(P.final_g + p * 512 + lane * 8); gv[p][1] = *(const f32x4*)(P.final_g + p * 512 + lane * 8 + 4); }
        for (int m = fn_first + wave; m < fn_end; m += fn_stride) {
            const float rs = row_rstd(ss6, m);
#pragma unroll
            for (int p = 0; p < 2; ++p) {
                const u32x4 w = *(const u32x4*)(xb + (size_t)m * D + p * 512 + lane * 8);
                const f32x4 v0 = (f32x4){__uint_as_float(w.x << 16), __uint_as_float(w.x & 0xffff0000u), __uint_as_float(w.y << 16), __uint_as_float(w.y & 0xffff0000u)};
                const f32x4 v1 = (f32x4){__uint_as_float(w.z << 16), __uint_as_float(w.z & 0xffff0000u), __uint_as_float(w.w << 16), __uint_as_float(w.w & 0xffff0000u)};
                float* o = P.out + (size_t)m * D + p * 512 + lane * 8;
                __builtin_nontemporal_store(v0 * rs * gv[p][0], (f32x4*)o); __builtin_nontemporal_store(v1 * rs * gv[p][1], (f32x4*)(o + 4));
            }
        }
    }
}
}

extern "C" void kernel_launch(void* const* d_in, const int* in_sizes, int n_in, void* d_out, int out_size, void* d_ws, size_t ws_size, hipStream_t stream) {
    static int grid = 0;
    if (grid == 0) {
        if (n_in != 15 || in_sizes[0] != mk::M * mk::D || out_size != mk::M * mk::D || ws_size < mk::WS_END) {
            fprintf(stderr, "kernel_launch: unexpected shapes (n_in %d, in0 %d, out %d, ws %zu); nothing launched\n", n_in, n_in > 0 ? in_sizes[0] : -1, out_size, ws_size); grid = -1; return; }
        int dev = 0, cus = 0, per_cu = 0;
        if (hipGetDevice(&dev) != hipSuccess || hipDeviceGetAttribute(&cus, hipDeviceAttributeMultiprocessorCount, dev) != hipSuccess) { grid = -1; return; }
        if (hipFuncSetAttribute((const void*)mk::mk_fwd, hipFuncAttributeMaxDynamicSharedMemorySize, mk::LDS_BYTES) != hipSuccess) { fprintf(stderr, "kernel_launch: hipFuncSetAttribute failed\n"); grid = -1; return; }
        if (hipOccupancyMaxActiveBlocksPerMultiprocessor(&per_cu, (const void*)mk::mk_fwd, mk::NTHREADS, mk::LDS_BYTES) != hipSuccess || per_cu < 1) { fprintf(stderr, "kernel_launch: occupancy query says %d\n", per_cu); per_cu = 1; }
        (void)hipGetLastError();
        grid = cus * per_cu;
    }
    if (grid < 0) return;
    mk::Args a{};
    for (int i = 0; i < 15; ++i) a.in[i] = (const float*)d_in[i];
    a.out = (float*)d_out; a.ws = (unsigned char*)d_ws;
    void* args[] = {&a};
    hipError_t e = hipLaunchCooperativeKernel((const void*)mk::mk_fwd, dim3(grid), dim3(mk::NTHREADS), args, mk::LDS_BYTES, stream);
    if (e != hipSuccess) fprintf(stderr, "kernel_launch: cooperative launch failed: %s (grid %d)\n", hipGetErrorString(e), grid);
}
```

```cpp
#include <hip/hip_runtime.h>
#include <hip/hip_cooperative_groups.h>
#include <cstdio>
#include <cstdint>
namespace cg = cooperative_groups;
namespace pg8 {
#define PG8_LAS __attribute__((address_space(3)))
typedef unsigned short bf16_t;
typedef short bf16x8 __attribute__((ext_vector_type(8)));
typedef float f32x4 __attribute__((ext_vector_type(4)));
typedef unsigned u32x4 __attribute__((ext_vector_type(4)));
constexpr int BM = 256, BK = 64, HALF = 128, HTB = HALF * BK * 2  , STAGE_BYTES = 8 * HTB, NXCD = 8, WGM = 8;

__host__ __device__ __forceinline__ int lds_byte(int r, int c) { const int st = (r >> 4) * 2 + (c >> 5), rr = r & 15, cc = c & 31, ob = rr * 64 + cc * 2; return st * 1024 + (ob ^ (((ob >> 9) & 1) << 5)); }
__host__ __device__ __forceinline__ void stage_rc(int b, int& R, int& C) { const int st = b / 1024, sb = b % 1024, swz = sb ^ (((sb >> 9) & 1) << 5); R = (st >> 1) * 16 + swz / 64; C = (st & 1) * 32 + (swz % 64) / 2; }
__host__ __device__ __forceinline__ int perm32(int rho) { const int n = rho >> 4, i = rho & 15; return 8 * (i >> 2) + 4 * n + (i & 3); }

struct Unit { int pm, pn; };
struct Gemm { const bf16_t* A; const bf16_t* Bt; int M, N, K; };

struct StaticOrder {
    int nM, nN, nwg, G, c;
    __host__ __device__ void init(int M, int N, int G_, int c_) { nM = M / BM; nN = N / BM; nwg = nM * nN; G = G_; c = c_; }
    __host__ __device__ bool next(int i, Unit& u) const {
        const long L = (long)i * G + c; if (L >= nwg) return false;
        int wgid = (int)L; { const int q = nwg / NXCD, r = nwg % NXCD, xcd = wgid % NXCD, off = wgid / NXCD; wgid = (xcd < r ? xcd * (q + 1) : r * (q + 1) + (xcd - r) * q) + off; }
        const int nig = WGM * nN, gid = wgid / nig, fm = gid * WGM, gsz = (nM - fm) < WGM ? (nM - fm) : WGM;
        u.pm = fm + ((wgid % nig) % gsz); u.pn = (wgid % nig) / gsz; return true;
    }
    __device__ __forceinline__ void a_ready(const Unit&) const {}
    __device__ __forceinline__ void done(const Unit&) const {}
};

__device__ __forceinline__ unsigned cvt_pk_bf16(float lo, float hi) { unsigned r; asm volatile("v_cvt_pk_bf16_f32 %0, %1, %2" : "=v"(r) : "v"(lo), "v"(hi)); return r; }
template <class Epi, class Sched, bool ALIGN_EPI = false, bool SP2 = false>
__device__ __forceinline__ void gemm_phase(PG8_LAS unsigned char* lds, const Gemm g, const Sched& S, const Epi& E) {
    int tid_ = threadIdx.x; asm volatile("" : "+v"(tid_));
    const int tid = tid_, wid = __builtin_amdgcn_readfirstlane(tid >> 6), lane = tid & 63, wr = wid >> 2, wc = wid & 3, fr = lane & 15, fq = lane >> 4;
    const int K = g.K, nt = K / BK;
    unsigned voffA[2], voffB[2];
#pragma unroll
    for (int i = 0; i < 2; ++i) { int R, C; stage_rc(tid * 16 + i * 8192, R, C); const int Rb = Epi::PERM ? ((R & ~31) + perm32(R & 31)) : R;
        voffA[i] = (unsigned)(R * K + C) * 2u; voffB[i] = (unsigned)(Rb * K + C) * 2u; }
    const size_t kstep = (size_t)(BK * 2);
    const size_t hstep = (size_t)HALF * K * 2;
    const size_t tstep = 2 * hstep;
    const unsigned ldsw = (unsigned)wid * 1024u;
    const int aoff = lds_byte(wr * 64 + fr, fq * 8), boff = lds_byte(wc * 32 + fr, fq * 8);
#define PG8_SA(b, h) (((b) * 2 + (h)) * HTB)
#define PG8_SB(b, h) ((4 + (b) * 2 + (h)) * HTB)
#define PG8_STAGE(bufoff, gbase, voff) do { _Pragma("unroll") for (int _i = 0; _i < 2; ++_i) \
        __builtin_amdgcn_global_load_lds((const unsigned*)((const char*)(gbase) + (voff)[_i]), (PG8_LAS unsigned*)(lds + (bufoff) + ldsw + _i * 8192), 16, 0, 0); } while (0)
#define PG8_LDA(dst, b, h) do { _Pragma("unroll") for (int m = 0; m < 4; ++m) _Pragma("unroll") for (int k = 0; k < 2; ++k) dst[m][k] = *(const PG8_LAS bf16x8*)(lds + PG8_SA(b, h) + aoff + m * 2048 + k * 1024); } while (0)
#define PG8_LDB(dst, b, h) do { _Pragma("unroll") for (int n = 0; n < 2; ++n) _Pragma("unroll") for (int k = 0; k < 2; ++k) dst[n][k] = *(const PG8_LAS bf16x8*)(lds + PG8_SB(b, h) + boff + n * 2048 + k * 1024); } while (0)
#define PG8_MMA(ai, bj, At, Bt) do { __builtin_amdgcn_s_setprio(1); _Pragma("unroll") for (int m = 0; m < 4; ++m) _Pragma("unroll") for (int n = 0; n < 2; ++n) _Pragma("unroll") for (int k = 0; k < 2; ++k) \
        acc[ai][bj][m][n] = __builtin_amdgcn_mfma_f32_16x16x32_bf16(Bt[n][k], At[m][k], acc[ai][bj][m][n], 0, 0, 0); __builtin_amdgcn_s_setprio(0); } while (0)
#define PG8_WAIT_V(n) asm volatile("s_waitcnt vmcnt(" #n ")" ::: "memory")
#define PG8_WAIT_L(n) asm volatile("s_waitcnt lgkmcnt(" #n ")" ::: "memory")
#define PG8_BAR __builtin_amdgcn_s_barrier()
#define PG8_SCHED __builtin_amdgcn_sched_barrier(0)
    Unit cur, nxt; int ui = 0;
    if (!S.next(0, cur)) return;
    f32x4 acc[2][2][4][2];
#pragma unroll
    for (int a = 0; a < 2; ++a)
#pragma unroll
        for (int b = 0; b < 2; ++b)
#pragma unroll
            for (int m = 0; m < 4; ++m)
#pragma unroll
                for (int n = 0; n < 2; ++n) acc[a][b][m][n] = (f32x4){0.f, 0.f, 0.f, 0.f};
    bf16x8 At[4][2], B0[2][2], B1[2][2];
    const char* cA = (const char*)g.A + (size_t)cur.pm * tstep; const char* cB = (const char*)g.Bt + (size_t)cur.pn * tstep;
    S.a_ready(cur);
    E.rs_first(cur, lds, tid);
    if constexpr (SP2) {
        PG8_STAGE(PG8_SB(0, 0), cB, voffB); PG8_STAGE(PG8_SB(0, 1), cB + hstep, voffB); PG8_STAGE(PG8_SA(0, 0), cA, voffA); PG8_STAGE(PG8_SA(0, 1), cA + hstep, voffA);
        if (wr == 1) PG8_BAR;
        PG8_WAIT_V(2); PG8_BAR;
        PG8_STAGE(PG8_SB(1, 0), cB + kstep, voffB); PG8_STAGE(PG8_SA(1, 0), cA + kstep, voffA); PG8_STAGE(PG8_SB(1, 1), cB + hstep + kstep, voffB);
        PG8_WAIT_V(6); PG8_BAR;
    } else {
        PG8_STAGE(PG8_SB(0, 0), cB, voffB); PG8_STAGE(PG8_SA(0, 0), cA, voffA); PG8_STAGE(PG8_SB(0, 1), cB + hstep, voffB); PG8_STAGE(PG8_SA(0, 1), cA + hstep, voffA);
        if (wr == 1) PG8_BAR;
        PG8_WAIT_V(4); PG8_BAR;
        PG8_STAGE(PG8_SB(1, 0), cB + kstep, voffB); PG8_STAGE(PG8_SA(1, 0), cA + kstep, voffA); PG8_STAGE(PG8_SB(1, 1), cB + hstep + kstep, voffB);
        PG8_WAIT_V(6); PG8_BAR;
    }
    for (;;) {
        const bool has_next = S.next(ui + 1, nxt);
        const char* nA = has_next ? (const char*)g.A + (size_t)nxt.pm * tstep : cA; const char* nB = has_next ? (const char*)g.Bt + (size_t)nxt.pn * tstep : cB;
        for (int t = 0; t < nt; t += 2) {
            const bool last = (t == nt - 2);
            const char* a1 = cA + (size_t)(t + 1) * kstep;
            const char* a2 = last ? nA : cA + (size_t)(t + 2) * kstep; const char* b2 = last ? nB : cB + (size_t)(t + 2) * kstep;
            const char* a3 = a2 + kstep; const char* b3 = b2 + kstep;
            if (last && has_next) S.a_ready(nxt);
            if constexpr (SP2) {
            const int relax = __builtin_amdgcn_readfirstlane((t == 0 && ui > 0) ? 1 : 0);
            PG8_LDB(B0, 0, 0); PG8_LDB(B1, 0, 1); PG8_SCHED; PG8_LDA(At, 0, 0); PG8_STAGE(PG8_SA(1, 1), a1 + hstep, voffA);
            asm volatile("s_cmp_lg_u32 %0, 0\n\ts_cbranch_scc1 .Lrelax%=\n\ts_waitcnt vmcnt(8)\n.Lrelax%=:\n\ts_waitcnt vmcnt(%1)" :: "s"(relax), "n"(8 + Epi::NST) : "memory", "scc");
            PG8_WAIT_L(0); PG8_BAR; PG8_MMA(0, 0, At, B0); PG8_MMA(0, 1, At, B1); PG8_BAR; PG8_SCHED;
            PG8_LDA(At, 0, 1); PG8_STAGE(PG8_SB(0, 0), b2, voffB); PG8_STAGE(PG8_SB(0, 1), b2 + hstep, voffB); PG8_STAGE(PG8_SA(0, 0), a2, voffA);
            asm volatile("s_cmp_lg_u32 %0, 0\n\ts_cbranch_scc1 .Lrelax%=\n\ts_waitcnt vmcnt(8)\n.Lrelax%=:\n\ts_waitcnt vmcnt(%1)" :: "s"(relax), "n"(8 + Epi::NST) : "memory", "scc");
            PG8_WAIT_L(0); PG8_BAR; PG8_MMA(1, 0, At, B0); PG8_MMA(1, 1, At, B1); PG8_BAR; PG8_SCHED;
            PG8_LDB(B0, 1, 0); PG8_LDB(B1, 1, 1); PG8_SCHED; PG8_LDA(At, 1, 0); PG8_STAGE(PG8_SA(0, 1), a2 + hstep, voffA);
            PG8_WAIT_V(8); PG8_WAIT_L(0); PG8_BAR; PG8_MMA(0, 0, At, B0); PG8_MMA(0, 1, At, B1); PG8_BAR; PG8_SCHED;
            PG8_LDA(At, 1, 1); PG8_STAGE(PG8_SB(1, 0), b3, voffB); PG8_STAGE(PG8_SB(1, 1), b3 + hstep, voffB); PG8_STAGE(PG8_SA(1, 0), a3, voffA);
            PG8_WAIT_V(8); PG8_WAIT_L(0); PG8_BAR; PG8_MMA(1, 0, At, B0); PG8_MMA(1, 1, At, B1); PG8_BAR; PG8_SCHED;
            } else {
            PG8_LDB(B0, 0, 0); PG8_SCHED; PG8_LDA(At, 0, 0); PG8_STAGE(PG8_SA(1, 1), a1 + hstep, voffA);
            PG8_WAIT_L(8); PG8_BAR; PG8_WAIT_L(0); PG8_MMA(0, 0, At, B0); PG8_BAR; PG8_SCHED;
            PG8_LDB(B1, 0, 1); PG8_STAGE(PG8_SB(0, 0), b2, voffB);
            PG8_BAR; PG8_WAIT_L(0); PG8_MMA(0, 1, At, B1); PG8_BAR;
            PG8_LDA(At, 0, 1); PG8_STAGE(PG8_SA(0, 0), a2, voffA);
            PG8_BAR; PG8_WAIT_L(0); PG8_MMA(1, 0, At, B0); PG8_BAR; PG8_SCHED;
            PG8_STAGE(PG8_SB(0, 1), b2 + hstep, voffB);
            PG8_WAIT_V(6); PG8_BAR; PG8_MMA(1, 1, At, B1); PG8_BAR;
            PG8_LDB(B0, 1, 0); PG8_SCHED; PG8_LDA(At, 1, 0); PG8_STAGE(PG8_SA(0, 1), a2 + hstep, voffA);
            PG8_WAIT_L(8); PG8_BAR; PG8_WAIT_L(0); PG8_MMA(0, 0, At, B0); PG8_BAR; PG8_SCHED;
            PG8_LDB(B1, 1, 1); PG8_STAGE(PG8_SB(1, 0), b3, voffB);
            PG8_BAR; PG8_WAIT_L(0); PG8_MMA(0, 1, At, B1); PG8_BAR;
            PG8_LDA(At, 1, 1); PG8_STAGE(PG8_SA(1, 0), a3, voffA);
            PG8_BAR; PG8_WAIT_L(0); PG8_MMA(1, 0, At, B0); PG8_BAR; PG8_SCHED;
            PG8_STAGE(PG8_SB(1, 1), b3 + hstep, voffB);
            PG8_WAIT_V(6); PG8_BAR; PG8_MMA(1, 1, At, B1); PG8_BAR;
            }
        }
        if constexpr (ALIGN_EPI) { if (wr == 0) PG8_BAR; }
        if constexpr (!Epi::AFTER_DRAIN) { E(acc, cur, wr, wc, fr, fq, lds, tid, ui, nxt, has_next); S.done(cur); }
        if (!has_next) break;
#pragma unroll
        for (int a = 0; a < 2; ++a)
#pragma unroll
            for (int b = 0; b < 2; ++b)
#pragma unroll
                for (int m = 0; m < 4; ++m)
#pragma unroll
                    for (int n = 0; n < 2; ++n) acc[a][b][m][n] = (f32x4){0.f, 0.f, 0.f, 0.f};
        cur = nxt; cA = nA; cB = nB; ++ui;
        if constexpr (ALIGN_EPI) { if (wr == 1) PG8_BAR; }
    }
    PG8_WAIT_V(0);
    if constexpr (!ALIGN_EPI) { if (wr == 0) PG8_BAR; }
    PG8_BAR;
    if constexpr (Epi::AFTER_DRAIN) { E.fused(acc, cur, wr, wc, fr, fq, lds, wid, lane); S.done(cur); }
#undef PG8_SA
#undef PG8_SB
#undef PG8_STAGE
#undef PG8_LDA
#undef PG8_LDB
#undef PG8_MMA
#undef PG8_WAIT_V
#undef PG8_WAIT_L
#undef PG8_BAR
#undef PG8_SCHED
}
}

namespace mk {
using pg8::bf16_t; using pg8::bf16x8; using pg8::f32x4; using pg8::u32x4; using pg8::Unit; using pg8::cvt_pk_bf16;
#define LAS __attribute__((address_space(3)))
typedef float f32x16 __attribute__((ext_vector_type(16)));
typedef short v4i16_t __attribute__((ext_vector_type(4)));
#define XB_TMO      128
#define XB_XCNT(j)  (256  + 64 * (j))
#define XB_XSUB(j)  (1280 + 64 * (j))
#define XB_XGEN(j)  (2304 + 64 * (j))
#define XB_TOP      3328
#define XB_TOPGEN   3392
#define XCD_BAR_WORDS 3456
#define XB_SPIN_CAP (1u << 18)

__device__ __forceinline__ unsigned xb_ld(unsigned* p)              { return __hip_atomic_load(p, __ATOMIC_RELAXED, __HIP_MEMORY_SCOPE_AGENT); }
__device__ __forceinline__ unsigned xb_add(unsigned* p, unsigned v) { return __hip_atomic_fetch_add(p, v, __ATOMIC_RELAXED, __HIP_MEMORY_SCOPE_AGENT); }
__device__ __forceinline__ unsigned xb_xcc_id() { return (unsigned)__builtin_amdgcn_s_getreg((3 << 11) | 20) & 0xFu; }
#define XB_SPIN(cond, bar) do { unsigned _sp = 0; while (cond) { __builtin_amdgcn_s_sleep(1); \
    if ((++_sp & 255u) == 0u) { if (xb_ld(&(bar)[XB_TMO])) break; if (_sp > XB_SPIN_CAP) { atomicAdd(&(bar)[XB_TMO], 1u); break; } } } } while (0)

struct XcdBarrier {
    unsigned* bar; unsigned x;
    volatile LAS unsigned* st;
};

__device__ __forceinline__ XcdBarrier xcd_barrier_post(unsigned* bar, volatile LAS unsigned* st) {
    XcdBarrier b; b.bar = bar; b.x = xb_xcc_id(); b.st = st;
    if (threadIdx.x == 0) (void)xb_add(&bar[XB_XCNT(b.x)], 1u);
    return b;
}
__device__ __forceinline__ void xcd_barrier_complete(unsigned* bar, unsigned x, unsigned& nloc, unsigned& nx) {
    const unsigned G = gridDim.x * gridDim.y * gridDim.z;
    unsigned sum, cnt, mine, sp = 0u;
    for (;;) {
        sum = 0u; cnt = 0u; mine = 0u;
#pragma unroll
        for (unsigned j = 0; j < 16; ++j) { const unsigned c = xb_ld(&bar[XB_XCNT(j)]); sum += c; cnt += (c > 0u) ? 1u : 0u; mine = (j == x) ? c : mine; }
        if (sum == G) break;
        __builtin_amdgcn_s_sleep(1);
        if ((++sp & 255u) == 0u) { if (xb_ld(&bar[XB_TMO])) break; if (sp > XB_SPIN_CAP) { atomicAdd(&bar[XB_TMO], 1u); break; } }
    }
    nloc = mine > 0u ? mine : 1u; nx = cnt > 0u ? cnt : 1u;
}

__device__ __forceinline__ void xcd_barrier(const XcdBarrier& b) {
    asm volatile("s_waitcnt vmcnt(0)" ::: "memory");
    __syncthreads();
    if (threadIdx.x == 0) {
        unsigned* bar = b.bar;
        __builtin_amdgcn_s_waitcnt(0);
        unsigned nloc = b.st[0], nx = b.st[1];
        if (nloc == 0u) { xcd_barrier_complete(bar, b.x, nloc, nx); b.st[0] = nloc; b.st[1] = nx; }
        const unsigned old = xb_add(&bar[XB_XSUB(b.x)], 1u);
        const unsigned gen = old / nloc;
        if (old + 1u == (gen + 1u) * nloc) {
            __builtin_amdgcn_fence(__ATOMIC_RELEASE, "agent");
            asm volatile("s_waitcnt vmcnt(0)" ::: "memory");
            const unsigned og = xb_add(&bar[XB_TOP], 1u);
            const unsigned tg = og / nx;
            if (og + 1u == (tg + 1u) * nx) xb_add(&bar[XB_TOPGEN], 1u);
            else XB_SPIN(xb_ld(&bar[XB_TOPGEN]) == tg, bar);
            __builtin_amdgcn_fence(__ATOMIC_ACQUIRE, "agent");
            xb_add(&bar[XB_XGEN(b.x)], 1u);
            asm volatile("s_waitcnt vmcnt(0)" ::: "memory");
        } else {
            XB_SPIN(xb_ld(&bar[XB_XGEN(b.x)]) == gen, bar);
            __builtin_amdgcn_fence(__ATOMIC_ACQUIRE, "agent");
            asm volatile("s_waitcnt vmcnt(0)" ::: "memory");
        }
    }
    __syncthreads();
}

#define XB_LSUB(j)  (3456 + 64 * (j))
#define XB_LGEN(j)  (3968 + 64 * (j))
#define XB_ALL_WORDS 4480
__device__ __forceinline__ void xcd_local_barrier(const XcdBarrier& b) {
    asm volatile("s_waitcnt vmcnt(0)" ::: "memory");
    __syncthreads();
    if (threadIdx.x == 0) {
        unsigned* bar = b.bar;
        __builtin_amdgcn_s_waitcnt(0);
        const unsigned nloc = b.st[0];
        const unsigned old = xb_add(&bar[XB_LSUB(b.x)], 1u);
        const unsigned gen = old / nloc;
        if (old + 1u == (gen + 1u) * nloc) xb_add(&bar[XB_LGEN(b.x)], 1u);
        else XB_SPIN(xb_ld(&bar[XB_LGEN(b.x)]) == gen, bar);
        __builtin_amdgcn_fence(__ATOMIC_ACQUIRE, "agent");
        asm volatile("s_waitcnt vmcnt(0)" ::: "memory");
    }
    __syncthreads();
}

constexpr int M = 32768, D = 1024, FF = 2816, SEQ = 4096, NB = 8, NH = 16, HD = 64, CW = 31;
constexpr float RMS_EPS = 1e-6f, LN_EPS = 1e-5f, LOG2E = 1.4426950408889634f;
constexpr int NWAVES = 8, NTHREADS = 512;
constexpr int LDS_BYTES = 147456;

constexpr size_t MiB = 1u << 20;
constexpr size_t WS_SSP = 0;
constexpr size_t SSP_STRIDE = (size_t)M * 16;
constexpr size_t WS_BAR = 15 * MiB;
constexpr size_t WS_WIN = 16 * MiB;
constexpr size_t WIN_STRIDE = (size_t)2 * FF * D;
constexpr size_t WS_WOUT = WS_WIN + 4 * WIN_STRIDE * 2;
constexpr size_t WOUT_STRIDE = (size_t)D * FF;
constexpr size_t WS_WPW1 = WS_WOUT + 4 * WOUT_STRIDE * 2;
constexpr size_t WS_WPW2 = WS_WPW1 + (size_t)2 * D * D * 2;
constexpr size_t WS_WQKV = WS_WPW2 + (size_t)D * D * 2;
constexpr size_t WS_WO = WS_WQKV + (size_t)3 * D * D * 2;
constexpr size_t WS_XB = 98 * MiB;
constexpr size_t WS_R = 162 * MiB;
constexpr size_t WS_O = 354 * MiB;
constexpr size_t WS_END = 418 * MiB;
static_assert(WS_WO + (size_t)D * D * 2 <= WS_XB, "ws map");
static_assert((size_t)M * FF * 2 <= 192 * MiB, "ws map");

__device__ __forceinline__ float sigm(float x) { return __builtin_amdgcn_rcpf(1.f + __builtin_amdgcn_exp2f(-LOG2E * x)); }
__device__ __forceinline__ float wave_sum(float v) {
#pragma unroll
    for (int o = 1; o < 64; o <<= 1) v += __shfl_xor(v, o);
    return v;
}
__device__ __forceinline__ float row_rstd(const float* ssp, int row) {
    const f32x4* p = (const f32x4*)(ssp + (size_t)row * 16);
    f32x4 a = p[0], b = p[1], c = p[2], d = p[3]; a = (a + b) + (c + d);
    return rsqrtf(((a.x + a.y) + (a.z + a.w)) * (1.f / D) + RMS_EPS);
}

constexpr int RS_LDS_OFF = 131072;
__device__ __forceinline__ void rs_issue(const float* ssp, const Unit& u, int tid, f32x4& a, f32x4& b) { const float* p = ssp + (size_t)(u.pm * 256 + (tid >> 1)) * 16 + 8 * (tid & 1); a = *(const f32x4*)p; b = *(const f32x4*)(p + 4); }
__device__ __forceinline__ void rs_finish(LAS unsigned char* lds, int buf, int tid, const f32x4& a, const f32x4& b) {
    float t = ((a.x + a.y) + (a.z + a.w)) + ((b.x + b.y) + (b.z + b.w)); t += __shfl_xor(t, 1);
    if (!(tid & 1)) ((LAS float*)(lds + RS_LDS_OFF))[buf * 256 + (tid >> 1)] = rsqrtf(t * (1.f / D) + RMS_EPS);
}
__device__ __forceinline__ void rs_read(LAS unsigned char* lds, int buf, int wr, int fr, float (&rs)[2][4]) {
    const LAS float* t = (const LAS float*)(lds + RS_LDS_OFF) + buf * 256 + wr * 64 + fr;
#pragma unroll
    for (int ai = 0; ai < 2; ++ai)
#pragma unroll
        for (int m = 0; m < 4; ++m) rs[ai][m] = t[ai * 128 + m * 16];
}
struct EpiSwiGLU {
    static constexpr bool PERM = true, AFTER_DRAIN = false; static constexpr int NST = 8;
    bf16_t* O; const float* ssp;
    __device__ __forceinline__ void rs_first(const Unit& u, LAS unsigned char* lds, int tid) const { f32x4 a, b; rs_issue(ssp, u, tid, a, b); rs_finish(lds, 0, tid, a, b); }
    __device__ __forceinline__ void operator()(const f32x4 (&acc)[2][2][4][2], const Unit& u, int wr, int wc, int fr, int fq, LAS unsigned char* lds, int tid, int ui, const Unit& nxt, bool has_next) const {
        f32x4 na, nb; if (has_next) rs_issue(ssp, nxt, tid, na, nb);
        const int row0 = u.pm * 256 + wr * 64 + fr, col0 = u.pn * 128 + wc * 32 + 8 * fq;
        float rsv[2][4]; rs_read(lds, ui & 1, wr, fr, rsv);
#pragma unroll
        for (int ai = 0; ai < 2; ++ai)
#pragma unroll
            for (int m = 0; m < 4; ++m) {
                const int row = row0 + ai * 128 + m * 16;
                const float rs = rsv[ai][m];
                typedef float f32x2 __attribute__((ext_vector_type(2)));
                const f32x2 rs2 = (f32x2){rs, rs}, nrs2 = (f32x2){-LOG2E * rs, -LOG2E * rs};
                unsigned wv[4];
#pragma unroll
                for (int n = 0; n < 2; ++n)
#pragma unroll
                    for (int hp = 0; hp < 2; ++hp) {
                        const f32x2 ag = (f32x2){acc[ai][0][m][n][2 * hp], acc[ai][0][m][n][2 * hp + 1]}, au = (f32x2){acc[ai][1][m][n][2 * hp], acc[ai][1][m][n][2 * hp + 1]};
                        const f32x2 g = ag * rs2, up = au * rs2, ne = ag * nrs2;
                        const f32x2 dd = (f32x2){__builtin_amdgcn_exp2f(ne.x), __builtin_amdgcn_exp2f(ne.y)} + 1.0f;
                        const f32x2 rr = (f32x2){__builtin_amdgcn_rcpf(dd.x), __builtin_amdgcn_rcpf(dd.y)};
                        const f32x2 oo = (g * rr) * up;
                        wv[n * 2 + hp] = cvt_pk_bf16(oo.x, oo.y);
                    }
                u32x4 w; w.x = wv[0]; w.y = wv[1]; w.z = wv[2]; w.w = wv[3];
                __builtin_nontemporal_store(w, (u32x4*)(O + (size_t)row * FF + col0));
            }
        if (has_next) rs_finish(lds, (ui + 1) & 1, tid, na, nb);
    }
};
struct EpiGLU {
    static constexpr bool PERM = true, AFTER_DRAIN = false; static constexpr int NST = 8;
    bf16_t* O; const float* ssp; const float* bias;
    __device__ __forceinline__ void rs_first(const Unit& u, LAS unsigned char* lds, int tid) const { f32x4 a, b; rs_issue(ssp, u, tid, a, b); rs_finish(lds, 0, tid, a, b); }
    __device__ __forceinline__ void operator()(const f32x4 (&acc)[2][2][4][2], const Unit& u, int wr, int wc, int fr, int fq, LAS unsigned char* lds, int tid, int ui, const Unit& nxt, bool has_next) const {
        f32x4 na, nb; if (has_next) rs_issue(ssp, nxt, tid, na, nb);
        const int row0 = u.pm * 256 + wr * 64 + fr, col0 = u.pn * 128 + wc * 32 + 8 * fq;
        f32x4 bv[2][2];
#pragma unroll
        for (int bj = 0; bj < 2; ++bj)
#pragma unroll
            for (int n = 0; n < 2; ++n) bv[bj][n] = *(const f32x4*)(bias + bj * D + col0 + 4 * n);
        float rsv[2][4]; rs_read(lds, ui & 1, wr, fr, rsv);
#pragma unroll
        for (int ai = 0; ai < 2; ++ai)
#pragma unroll
            for (int m = 0; m < 4; ++m) {
                const int row = row0 + ai * 128 + m * 16;
                const float rs = rsv[ai][m];
                float o[8];
#pragma unroll
                for (int n = 0; n < 2; ++n)
#pragma unroll
                    for (int e = 0; e < 4; ++e) { const float v = acc[ai][0][m][n][e] * rs + bv[0][n][e], g = acc[ai][1][m][n][e] * rs + bv[1][n][e]; o[n * 4 + e] = v * sigm(g); }
                u32x4 w; w.x = cvt_pk_bf16(o[0], o[1]); w.y = cvt_pk_bf16(o[2], o[3]); w.z = cvt_pk_bf16(o[4], o[5]); w.w = cvt_pk_bf16(o[6], o[7]);
                *(u32x4*)(O + (size_t)row * D + col0) = w;
            }
        if (has_next) rs_finish(lds, (ui + 1) & 1, tid, na, nb);
    }
};
struct EpiQKV {
    static constexpr bool PERM = true, AFTER_DRAIN = false; static constexpr int NST = 16;
    bf16_t* O; const float* ssp; size_t tstride;
    __device__ __forceinline__ void rs_first(const Unit& u, LAS unsigned char* lds, int tid) const { f32x4 a, b; rs_issue(ssp, u, tid, a, b); rs_finish(lds, 0, tid, a, b); }
    __device__ __forceinline__ void operator()(const f32x4 (&acc)[2][2][4][2], const Unit& u, int wr, int wc, int fr, int fq, LAS unsigned char* lds, int tid, int ui, const Unit& nxt, bool has_next) const {
        f32x4 na, nb; if (has_next) rs_issue(ssp, nxt, tid, na, nb);
        const int row0 = u.pm * 256 + wr * 64 + fr; const int t = u.pn >> 2;
        bf16_t* base = O + (size_t)t * tstride; const int col0 = (u.pn & 3) * 256 + wc * 32 + 8 * fq;
        float rsv[2][4]; rs_read(lds, ui & 1, wr, fr, rsv);
#pragma unroll
        for (int ai = 0; ai < 2; ++ai)
#pragma unroll
            for (int m = 0; m < 4; ++m) {
                const int row = row0 + ai * 128 + m * 16;
                const float rs = rsv[ai][m];
#pragma unroll
                for (int bj = 0; bj < 2; ++bj) {
                    const f32x4 v0 = acc[ai][bj][m][0] * rs, v1 = acc[ai][bj][m][1] * rs;
                    u32x4 w; w.x = cvt_pk_bf16(v0[0], v0[1]); w.y = cvt_pk_bf16(v0[2], v0[3]); w.z = cvt_pk_bf16(v1[0], v1[1]); w.w = cvt_pk_bf16(v1[2], v1[3]);
                    *(u32x4*)(base + (size_t)row * D + col0 + bj * 128) = w;
                }
            }
        if (has_next) rs_finish(lds, (ui + 1) & 1, tid, na, nb);
    }
};
struct EpiResid {
    static constexpr bool PERM = true, AFTER_DRAIN = false; static constexpr int NST = 24;
    bf16_t* xb; float* ssp; const float* bias; float alpha;
    __device__ __forceinline__ void rs_first(const Unit&, LAS unsigned char*, int) const {}
    __device__ __forceinline__ void operator()(const f32x4 (&acc)[2][2][4][2], const Unit& u, int wr, int wc, int fr, int fq, LAS unsigned char* lds, int tid, int ui, const Unit& nxt, bool has_next) const {
        const int row0 = u.pm * 256 + wr * 64 + fr, col0 = u.pn * 256 + wc * 32 + 8 * fq;
        f32x4 bv[2][2];
#pragma unroll
        for (int bj = 0; bj < 2; ++bj)
#pragma unroll
            for (int n = 0; n < 2; ++n) bv[bj][n] = bias ? *(const f32x4*)(bias + col0 + bj * 128 + 4 * n) : (f32x4){0.f, 0.f, 0.f, 0.f};
#pragma unroll
        for (int ai = 0; ai < 2; ++ai) {
            u32x4 xr[4][2];
#pragma unroll
            for (int m = 0; m < 4; ++m)
#pragma unroll
                for (int bj = 0; bj < 2; ++bj) xr[m][bj] = *(const u32x4*)(xb + (size_t)(row0 + ai * 128 + m * 16) * D + col0 + bj * 128);
#pragma unroll
            for (int m = 0; m < 4; ++m) {
                const int row = row0 + ai * 128 + m * 16; const size_t off = (size_t)row * D + col0;
                typedef float f32x2 __attribute__((ext_vector_type(2)));
                f32x2 sq2 = (f32x2){0.f, 0.f};
#pragma unroll
                for (int bj = 0; bj < 2; ++bj) {
                    f32x2 v[4];
                    const u32x4 w0 = xr[m][bj];
#pragma unroll
                    for (int i = 0; i < 4; ++i) v[i] = (f32x2){__uint_as_float(w0[i] << 16), __uint_as_float(w0[i] & 0xffff0000u)};
                    const f32x2 al2 = (f32x2){alpha, alpha};
                    unsigned wv[4];
#pragma unroll
                    for (int i = 0; i < 4; ++i) {
                        const f32x4 av = acc[ai][bj][m][i >> 1], bb = bv[bj][i >> 1];
                        const f32x2 a2 = (i & 1) ? (f32x2){av.z, av.w} : (f32x2){av.x, av.y}, b2 = (i & 1) ? (f32x2){bb.z, bb.w} : (f32x2){bb.x, bb.y};
                        v[i] = __builtin_elementwise_fma(a2, al2, v[i]) + b2;
                        sq2 = __builtin_elementwise_fma(v[i], v[i], sq2);
                        wv[i] = cvt_pk_bf16(v[i].x, v[i].y);
                    }
                    u32x4 w; w.x = wv[0]; w.y = wv[1]; w.z = wv[2]; w.w = wv[3];
                    *(u32x4*)(xb + off + bj * 128) = w;
                }
                float sq = sq2.x + sq2.y;
                sq += __shfl_xor(sq, 16); sq += __shfl_xor(sq, 32);
                if (fq == 0) ssp[(size_t)row * 16 + u.pn * 4 + wc] = sq;
            }
            asm volatile("" ::: "memory");
        }
    }
};

__device__ __forceinline__ void transpose_item(const float* W, int K, int N, const float* g, bf16_t* WT, int glu_h, LAS float* scr, int item, int lane) {
    const int nblk = N / 64, kb = item / nblk, nb = item % nblk, k0 = 64 * kb, n0 = 64 * nb;
    const int lr = lane >> 4, c4 = lane & 15;
    f32x4 v[16];
#pragma unroll
    for (int i = 0; i < 16; ++i) v[i] = __builtin_nontemporal_load((const f32x4*)(W + (size_t)(k0 + 4 * i + lr) * N + n0 + 4 * c4));
    if (g) {
#pragma unroll
        for (int i = 0; i < 16; ++i) v[i] = v[i] * g[k0 + 4 * i + lr];
    }
#pragma unroll
    for (int i = 0; i < 16; ++i) { LAS float* d = scr + (4 * i + lr) * 65 + 4 * c4; d[0] = v[i].x; d[1] = v[i].y; d[2] = v[i].z; d[3] = v[i].w; }
    asm volatile("s_waitcnt lgkmcnt(0)" ::: "memory");
    int drow0 = n0;
    if (glu_h) { const int up = n0 >= glu_h, c = up ? n0 - glu_h : n0; drow0 = (c >> 7) * 256 + up * 128 + (c & 127); }
    const int c = lane & 7;
#pragma unroll
    for (int j = 0; j < 8; ++j) { const int n = (lane >> 3) + 8 * j; const LAS float* p = scr + (8 * c) * 65 + n;
        u32x4 o; o.x = cvt_pk_bf16(p[0 * 65], p[1 * 65]); o.y = cvt_pk_bf16(p[2 * 65], p[3 * 65]); o.z = cvt_pk_bf16(p[4 * 65], p[5 * 65]); o.w = cvt_pk_bf16(p[6 * 65], p[7 * 65]);
        *(u32x4*)(WT + (size_t)(drow0 + n) * K + k0 + 8 * c) = o; }
    asm volatile("s_waitcnt lgkmcnt(0)" ::: "memory");
}

struct Ptrs {
    const float *x, *norm_g, *final_g, *ffn_w_in, *ffn_w_out, *w_pw1, *b_pw1, *w_dw, *b_dw, *ln_g, *ln_b, *w_pw2, *b_pw2, *w_qkv, *w_o;
    float* out; unsigned char* ws;
};

__device__ __forceinline__ void prologue(const Ptrs& P, LAS unsigned char* lds, int vcu, int G, int wave, int lane) {
    LAS float* scr = (LAS float*)(lds + wave * 18432);
    const int gw = vcu * NWAVES + wave, NGW = G * NWAVES;
    constexpr int I_IN = (D / 64) * (2 * FF / 64), I_OUT = (FF / 64) * (D / 64), I_PW1 = (D / 64) * (2 * D / 64), I_SQ = (D / 64) * (D / 64), I_QKV = (D / 64) * (3 * D / 64);
    constexpr int NITEMS = 4 * I_IN + 4 * I_OUT + I_PW1 + I_SQ + I_QKV + I_SQ;
    bf16_t* ws16 = (bf16_t*)P.ws;
    for (int it = gw; it < NITEMS; it += NGW) {
        int r = it; const float* W; const float* g = nullptr; bf16_t* WT; int K = D, N = D, glu = 0;
        if (r < 4 * I_IN) { const int idx = r / I_IN, l = idx >> 1, j = idx & 1; r -= idx * I_IN;
            W = P.ffn_w_in + (size_t)idx * D * 2 * FF; N = 2 * FF; g = P.norm_g + (l * 3 + (j ? 2 : 0)) * D; WT = (bf16_t*)(P.ws + WS_WIN) + idx * WIN_STRIDE; glu = FF; }
        else if ((r -= 4 * I_IN) < 4 * I_OUT) { const int idx = r / I_OUT; r -= idx * I_OUT;
            W = P.ffn_w_out + (size_t)idx * FF * D; K = FF; WT = (bf16_t*)(P.ws + WS_WOUT) + idx * WOUT_STRIDE; }
        else if ((r -= 4 * I_OUT) < I_PW1) { W = P.w_pw1; N = 2 * D; g = P.norm_g + 1 * D; WT = (bf16_t*)(P.ws + WS_WPW1); glu = D; }
        else if ((r -= I_PW1) < I_SQ) { W = P.w_pw2; WT = (bf16_t*)(P.ws + WS_WPW2); }
        else if ((r -= I_SQ) < I_QKV) { W = P.w_qkv; N = 3 * D; g = P.norm_g + 4 * D; WT = (bf16_t*)(P.ws + WS_WQKV); }
        else { r -= I_QKV; W = P.w_o; WT = (bf16_t*)(P.ws + WS_WO); }
        transpose_item(W, K, N, g, WT, glu, scr, r, lane);
    }
    (void)ws16;
    bf16_t* xb = (bf16_t*)(P.ws + WS_XB); float* ssp0 = (float*)(P.ws + WS_SSP);
    for (int m0 = gw; m0 < M; m0 += 2 * NGW) {
        f32x4 v[2][4]; float sq[2];
#pragma unroll
        for (int t = 0; t < 2; ++t) { const f32x4* xr = (const f32x4*)(P.x + (size_t)((t && m0 + NGW >= M) ? m0 : m0 + t * NGW) * D) + lane;
#pragma unroll
            for (int j = 0; j < 4; ++j) v[t][j] = __builtin_nontemporal_load(xr + 64 * j); }
#pragma unroll
        for (int t = 0; t < 2; ++t) { float s_ = 0.f;
#pragma unroll
            for (int j = 0; j < 4; ++j) s_ += (v[t][j].x * v[t][j].x + v[t][j].y * v[t][j].y) + (v[t][j].z * v[t][j].z + v[t][j].w * v[t][j].w);
            sq[t] = wave_sum(s_); }
#pragma unroll
        for (int t = 0; t < 2; ++t) { const int m = (t && m0 + NGW >= M) ? m0 : m0 + t * NGW;
            unsigned long long* o8 = (unsigned long long*)(xb + (size_t)m * D) + lane;
#pragma unroll
            for (int j = 0; j < 4; ++j) o8[64 * j] = (unsigned long long)cvt_pk_bf16(v[t][j].x, v[t][j].y) | ((unsigned long long)cvt_pk_bf16(v[t][j].z, v[t][j].w) << 32);
            if (lane < 16) ssp0[(size_t)m * 16 + lane] = lane == 0 ? sq[t] : 0.f; }
    }
}

__device__ __forceinline__ void conv_phase(LAS unsigned char* lds, const bf16_t* U, bf16_t* C, const float* wdw, const float* bdw, const float* lng, const float* lnb,
                                           int first, int stride, int end, int tid, int wave, int lane) {
    constexpr int TT = 32, ROWS = TT + CW - 1;
    for (int tile = first; tile < end; tile += stride) {
        const int t0 = tile * TT, tin = t0 % SEQ;
        for (int idx = tid; idx < ROWS * 128; idx += NTHREADS) {
            const int row = idx >> 7, ch = idx & 127;
            u32x4 v = (u32x4){0u, 0u, 0u, 0u};
            if (tin + row - (CW - 1) >= 0) v = *(const u32x4*)(U + (size_t)(t0 + row - (CW - 1)) * D + ch * 8);
            *(LAS u32x4*)(lds + row * 2048 + ch * 16) = v;
        }
        asm volatile("s_waitcnt lgkmcnt(0)" ::: "memory"); __builtin_amdgcn_s_barrier(); asm volatile("" ::: "memory");
        typedef float f32x2 __attribute__((ext_vector_type(2)));
        f32x2 acc[2][4][4];
#pragma unroll
        for (int p = 0; p < 2; ++p) {
#pragma unroll
            for (int j = 0; j < 4; ++j)
#pragma unroll
                for (int c = 0; c < 4; ++c) acc[p][j][c] = (f32x2){0.f, 0.f};
            f32x4 wt[8][2];
            const float* wq = wdw + p * 512 + lane * 8;
#pragma unroll
            for (int t = 0; t < 4; ++t) { wt[t][0] = *(const f32x4*)(wq); wt[t][1] = *(const f32x4*)(wq + 4); wq += D; asm volatile("" : "+v"(wq)); }
#pragma unroll
            for (int r = 0; r < TT / NWAVES + CW - 1; ++r) {
                if (r + 4 < CW) { wt[(r + 4) & 7][0] = *(const f32x4*)(wq); wt[(r + 4) & 7][1] = *(const f32x4*)(wq + 4); wq += D; asm volatile("" : "+v"(wq)); }
                const u32x4 xv = *(const LAS u32x4*)(lds + (4 * wave + r) * 2048 + p * 1024 + lane * 16);
                f32x2 x[4];
#pragma unroll
                for (int i = 0; i < 4; ++i) x[i] = (f32x2){__uint_as_float(xv[i] << 16), __uint_as_float(xv[i] & 0xffff0000u)};
#pragma unroll
                for (int j = 0; j < 4; ++j) { const int w = r - j;
                    if (w >= 0 && w < CW) {
#pragma unroll
                        for (int c = 0; c < 4; ++c) { const f32x4 wv = wt[w & 7][c >> 1]; const f32x2 w2 = (c & 1) ? (f32x2){wv.z, wv.w} : (f32x2){wv.x, wv.y}; acc[p][j][c] = __builtin_elementwise_fma(w2, x[c], acc[p][j][c]); } } }
                asm volatile("" ::: "memory");
            }
            const f32x4 b0 = *(const f32x4*)(bdw + p * 512 + lane * 8), b1 = *(const f32x4*)(bdw + p * 512 + lane * 8 + 4);
#pragma unroll
            for (int j = 0; j < 4; ++j) { acc[p][j][0] += (f32x2){b0.x, b0.y}; acc[p][j][1] += (f32x2){b0.z, b0.w}; acc[p][j][2] += (f32x2){b1.x, b1.y}; acc[p][j][3] += (f32x2){b1.z, b1.w}; }
        }
        float mean[4], rstd[4];
#pragma unroll
        for (int j = 0; j < 4; ++j) { f32x2 s2 = (f32x2){0.f, 0.f};
#pragma unroll
            for (int p = 0; p < 2; ++p)
#pragma unroll
                for (int c = 0; c < 4; ++c) s2 += acc[p][j][c];
            mean[j] = wave_sum(s2.x + s2.y) * (1.f / D); f32x2 q2 = (f32x2){0.f, 0.f};
#pragma unroll
            for (int p = 0; p < 2; ++p)
#pragma unroll
                for (int c = 0; c < 4; ++c) { const f32x2 d = acc[p][j][c] - mean[j]; q2 += d * d; }
            rstd[j] = rsqrtf(wave_sum(q2.x + q2.y) * (1.f / D) + LN_EPS); }
#pragma unroll
        for (int p = 0; p < 2; ++p) {
            const f32x4 g0 = *(const f32x4*)(lng + p * 512 + lane * 8), g1 = *(const f32x4*)(lng + p * 512 + lane * 8 + 4);
            const f32x4 c0 = *(const f32x4*)(lnb + p * 512 + lane * 8), c1 = *(const f32x4*)(lnb + p * 512 + lane * 8 + 4);
            const float gg[8] = {g0.x, g0.y, g0.z, g0.w, g1.x, g1.y, g1.z, g1.w}, bb[8] = {c0.x, c0.y, c0.z, c0.w, c1.x, c1.y, c1.z, c1.w};
#pragma unroll
            for (int j = 0; j < 4; ++j) { float o[8];
#pragma unroll
                for (int c = 0; c < 8; ++c) { const float y = (acc[p][j][c >> 1][c & 1] - mean[j]) * rstd[j] * gg[c] + bb[c]; o[c] = y * sigm(y); }
                u32x4 w; w.x = cvt_pk_bf16(o[0], o[1]); w.y = cvt_pk_bf16(o[2], o[3]); w.z = cvt_pk_bf16(o[4], o[5]); w.w = cvt_pk_bf16(o[6], o[7]);
                *(u32x4*)(C + (size_t)(t0 + 4 * wave + j) * D + p * 512 + lane * 8) = w; }
        }
        asm volatile("s_waitcnt lgkmcnt(0)" ::: "memory"); __builtin_amdgcn_s_barrier(); asm volatile("" ::: "memory");
    }
}

__device__ __forceinline__ void attn_phase(LAS unsigned char* lds, const bf16_t* Q, const bf16_t* Kp, const bf16_t* Vp, bf16_t* O, int first, int stride, int end, int wave, int lane) {
    const int r32 = lane & 31, hi = lane >> 5;
    LAS unsigned char* vl = lds + wave * 8704;
    LAS unsigned char* kl = vl + 4096;
    const int trb = (4 * hi + ((lane & 15) >> 2)) * 128 + ((lane >> 4) & 1) * 32 + (lane & 3) * 8;
    for (int u = first + wave; u < end; u += stride) {
        const int bh = u >> 7, qblk = u & 127, b = bh >> 4, h = bh & 15;
        const size_t rowbase = (size_t)b * SEQ;
        const bf16_t* Qw = Q + (rowbase + qblk * 32 + r32) * D + h * HD + hi * 8;
        bf16x8 qr[4];
#pragma unroll
        for (int d0 = 0; d0 < 4; ++d0) qr[d0] = *(const bf16x8*)(Qw + d0 * 16);
        const bf16_t* Kl = Kp + (rowbase + (lane >> 3)) * D + h * HD + (lane & 7) * 8;
        const bf16_t* Vl = Vp + (rowbase + (lane >> 3)) * D + h * HD + (lane & 7) * 8;
        u32x4 kn[4]; u32x4 vn[4];
#pragma unroll
        for (int i = 0; i < 4; ++i) { kn[i] = *(const u32x4*)(Kl + (size_t)(qblk * 32 + 8 * i) * D); vn[i] = *(const u32x4*)(Vl + (size_t)(qblk * 32 + 8 * i) * D); }
        f32x16 o0 = {}, o1 = {}; float carry = 1.f;
        for (int kt = qblk; kt >= 0; --kt) {
#pragma unroll
            for (int i = 0; i < 4; ++i) { *(LAS u32x4*)(vl + ((lane >> 3) + 8 * i) * 128 + (lane & 7) * 16) = vn[i]; *(LAS u32x4*)(kl + ((lane >> 3) + 8 * i) * 144 + (lane & 7) * 16) = kn[i]; }
            bf16x8 kc[4];
#pragma unroll
            for (int i = 0; i < 4; ++i) kc[i] = *(const LAS bf16x8*)(kl + r32 * 144 + i * 32 + hi * 16);
            if (kt > 0) {
#pragma unroll
                for (int i = 0; i < 4; ++i) { kn[i] = *(const u32x4*)(Kl + (size_t)((kt - 1) * 32 + 8 * i) * D); vn[i] = *(const u32x4*)(Vl + (size_t)((kt - 1) * 32 + 8 * i) * D); }
            }
            f32x16 p = {};
#pragma unroll
            for (int d0 = 0; d0 < 4; ++d0) p = __builtin_amdgcn_mfma_f32_32x32x16_bf16(kc[d0], qr[d0], p, 0, 0, 0);
            const bool diag = (kt == qblk);
            float beta[16], om[16];
#pragma unroll
            for (int r = 0; r < 16; ++r) {
                const float z = p[r] * 0.125f, e = __builtin_amdgcn_exp2f(-LOG2E * __builtin_fabsf(z)), rc = __builtin_amdgcn_rcpf(1.f + e), sm = e * rc;
                const bool pos = z >= 0.f; float bt = pos ? rc : sm, o_ = pos ? sm : rc;
                const int kvl = (r & 3) + 8 * (r >> 2) + 4 * hi;
                if (diag && kvl >= r32) { bt = 0.f; o_ = 1.f; }
                beta[r] = bt; om[r] = o_;
            }
            float Gm[4], Gp[4];
#pragma unroll
            for (int g = 0; g < 4; ++g) { Gm[g] = (om[4 * g] * om[4 * g + 1]) * (om[4 * g + 2] * om[4 * g + 3]); Gp[g] = __shfl_xor(Gm[g], 32); }
            float SO[4], SP[4];
            SO[3] = 1.f; SO[2] = Gm[3]; SO[1] = SO[2] * Gm[2]; SO[0] = SO[1] * Gm[1];
            SP[3] = 1.f; SP[2] = Gp[3]; SP[1] = SP[2] * Gp[2]; SP[0] = SP[1] * Gp[1];
            float A[16];
#pragma unroll
            for (int g = 0; g < 4; ++g) {
                const float E = carry * SO[g] * (hi ? SP[g] : SP[g] * Gp[g]);
                const float P3 = E, P2 = P3 * om[4 * g + 3], P1 = P2 * om[4 * g + 2], P0 = P1 * om[4 * g + 1];
                A[4 * g + 3] = beta[4 * g + 3] * P3; A[4 * g + 2] = beta[4 * g + 2] * P2; A[4 * g + 1] = beta[4 * g + 1] * P1; A[4 * g] = beta[4 * g] * P0;
            }
            carry = carry * (SO[0] * Gm[0]) * (SP[0] * Gp[0]);
            u32x4 pw0, pw1;
            pw0.x = cvt_pk_bf16(A[0], A[1]); pw0.y = cvt_pk_bf16(A[2], A[3]); pw0.z = cvt_pk_bf16(A[4], A[5]); pw0.w = cvt_pk_bf16(A[6], A[7]);
            pw1.x = cvt_pk_bf16(A[8], A[9]); pw1.y = cvt_pk_bf16(A[10], A[11]); pw1.z = cvt_pk_bf16(A[12], A[13]); pw1.w = cvt_pk_bf16(A[14], A[15]);
            const bf16x8 pa0 = __builtin_bit_cast(bf16x8, pw0), pa1 = __builtin_bit_cast(bf16x8, pw1);
            asm volatile("s_waitcnt lgkmcnt(0)" ::: "memory");
#pragma unroll
            for (int s = 0; s < 2; ++s)
#pragma unroll
                for (int d0 = 0; d0 < 2; ++d0) {
                    const v4i16_t lo = __builtin_amdgcn_ds_read_tr16_b64_v4i16((LAS v4i16_t*)(vl + trb + s * 2048 + d0 * 64));
                    const v4i16_t hh = __builtin_amdgcn_ds_read_tr16_b64_v4i16((LAS v4i16_t*)(vl + trb + s * 2048 + 1024 + d0 * 64));
                    const bf16x8 vf = (bf16x8){lo[0], lo[1], lo[2], lo[3], hh[0], hh[1], hh[2], hh[3]};
                    if (d0 == 0) o0 = __builtin_amdgcn_mfma_f32_32x32x16_bf16(s ? pa1 : pa0, vf, o0, 0, 0, 0);
                    else         o1 = __builtin_amdgcn_mfma_f32_32x32x16_bf16(s ? pa1 : pa0, vf, o1, 0, 0, 0);
                }
            asm volatile("s_waitcnt lgkmcnt(0)" ::: "memory");
            if (__builtin_amdgcn_ballot_w64(carry > 5.4210109e-20f) == 0ull) break;
        }
        bf16_t* Ow = O + (rowbase + qblk * 32) * D + h * HD + r32;
#pragma unroll
        for (int r = 0; r < 16; ++r) { const int q = (r & 3) + 8 * (r >> 2) + 4 * hi;
            const unsigned w = cvt_pk_bf16(o0[r], o1[r]);
            Ow[(size_t)q * D] = (bf16_t)(w & 0xffffu); Ow[(size_t)q * D + 32] = (bf16_t)(w >> 16); }
    }
}

struct Args { const float* in[15]; float* out; unsigned char* ws; };

__global__ void __launch_bounds__(NTHREADS, 2) mk_fwd(Args a) {
    extern __shared__ __attribute__((aligned(16))) unsigned char lds_[];
    LAS unsigned char* lds = (LAS unsigned char*)lds_;
    cg::grid_group grid = cg::this_grid();
    int tid = threadIdx.x, lane = tid & 63, wave = __builtin_amdgcn_readfirstlane(tid >> 6);
    const int G = gridDim.x, bx = blockIdx.x, vcu = (G % 8 == 0) ? (bx % 8) * (G / 8) + bx / 8 : bx;
    Ptrs P;
    P.x = a.in[0]; P.norm_g = a.in[1]; P.final_g = a.in[2]; P.ffn_w_in = a.in[3]; P.ffn_w_out = a.in[4]; P.w_pw1 = a.in[5]; P.b_pw1 = a.in[6]; P.w_dw = a.in[7]; P.b_dw = a.in[8];
    P.ln_g = a.in[9]; P.ln_b = a.in[10]; P.w_pw2 = a.in[11]; P.b_pw2 = a.in[12]; P.w_qkv = a.in[13]; P.w_o = a.in[14]; P.out = a.out; P.ws = a.ws;
    float* ssp = (float*)(P.ws + WS_SSP);
    bf16_t* Win = (bf16_t*)(P.ws + WS_WIN); bf16_t* Wout = (bf16_t*)(P.ws + WS_WOUT);
    bf16_t* Wpw1 = (bf16_t*)(P.ws + WS_WPW1); bf16_t* Wpw2 = (bf16_t*)(P.ws + WS_WPW2); bf16_t* Wqkv = (bf16_t*)(P.ws + WS_WQKV); bf16_t* Wo = (bf16_t*)(P.ws + WS_WO);
    bf16_t* xb = (bf16_t*)(P.ws + WS_XB); bf16_t* R = (bf16_t*)(P.ws + WS_R); bf16_t* Ob = (bf16_t*)(P.ws + WS_O);

    prologue(P, lds, vcu, G, wave, lane);
    unsigned* barw = (unsigned*)(P.ws + WS_BAR);
    if (bx == 0) { for (int i = threadIdx.x; i < XB_ALL_WORDS; i += NTHREADS) __hip_atomic_store(barw + i, 0u, __ATOMIC_RELAXED, __HIP_MEMORY_SCOPE_AGENT); }
    volatile LAS unsigned* bst = (volatile LAS unsigned*)(lds + LDS_BYTES - 16);
    unsigned* slots = barw + XB_ALL_WORDS;
    XcdBarrier bar; bar.bar = barw; bar.x = xb_xcc_id(); bar.st = bst;
    volatile LAS unsigned* cen = (volatile LAS unsigned*)(lds + 1024);
    if (threadIdx.x < 4) bst[threadIdx.x] = 0u;
    if (threadIdx.x < 17) cen[threadIdx.x] = 0u;
    if (threadIdx.x == 0) __hip_atomic_store(slots + bx, bar.x, __ATOMIC_RELAXED, __HIP_MEMORY_SCOPE_AGENT);
    grid.sync();
    for (int t = threadIdx.x; t < G; t += NTHREADS) {
        const unsigned v = __hip_atomic_load(slots + t, __ATOMIC_RELAXED, __HIP_MEMORY_SCOPE_AGENT) & 15u;
        __hip_atomic_fetch_add((LAS unsigned*)(lds + 1024) + v, 1u, __ATOMIC_RELAXED, __HIP_MEMORY_SCOPE_WORKGROUP);
        if (v == bar.x && t < bx) __hip_atomic_fetch_add((LAS unsigned*)(lds + 1024) + 16, 1u, __ATOMIC_RELAXED, __HIP_MEMORY_SCOPE_WORKGROUP);
    }
    __syncthreads();
    if (threadIdx.x == 0) {
        unsigned ok = (G % 8 == 0) && (bar.x < 8u) ? 1u : 0u, nx = 0u;
        for (unsigned j = 0; j < 16; ++j) { const unsigned c = cen[j]; nx += c ? 1u : 0u; if (c != (j < 8u ? (unsigned)(G / 8) : 0u)) ok = 0u; }
        bst[0] = cen[bar.x]; bst[1] = nx ? nx : 1u;
        bst[2] = cen[16]; bst[3] = ok;
    }
    __syncthreads();
#pragma unroll 1
    for (int l = 0; l < 2; ++l) {
#pragma unroll 1
        for (int s = 0; s < 7; ++s) {
            tid = threadIdx.x; asm volatile("" : "+v"(tid)); lane = tid & 63; wave = __builtin_amdgcn_readfirstlane(tid >> 6);
            const bool local = bst[3] != 0u; const int xq = (int)bar.x, rank = (int)bst[2], nl = G / 8;
            const int vb = local ? xq + 8 * rank : bx;
            const size_t SLAB = (size_t)12 * 1024 * 1024, T8 = (size_t)4 * 1024 * 1024;
            bf16_t* Rx = local ? R + (size_t)xq * SLAB : R; const size_t ro = local ? (size_t)xq * SEQ : 0;
            bf16_t* act = Rx - ro * FF; bf16_t* ub = Rx - ro * D; bf16_t* cb = (local ? Rx + T8 : R + (size_t)M * D) - ro * D;
            bf16_t* qb = ub; bf16_t* kb = cb; bf16_t* vb_ = (local ? Rx + 2 * T8 : R + (size_t)2 * M * D) - ro * D;
            const size_t qkv_stride = local ? T8 : (size_t)M * D;
            if (s == 0 || s == 5) {
                const int j = s == 0 ? 0 : 1;
                pg8::Gemm g{xb, Win + (size_t)(l * 2 + j) * WIN_STRIDE, M, 2 * FF, D}; pg8::StaticOrder S; S.init(M, 2 * FF, G, vb);
                EpiSwiGLU E{act, ssp + (size_t)(3 * l + (j ? 2 : 0)) * SSP_STRIDE};
                pg8::gemm_phase<EpiSwiGLU, pg8::StaticOrder, true, true>(lds, g, S, E);
            } else if (s == 1 || s == 4 || s == 6) {
                const bf16_t* A; const bf16_t* W; int K; float alpha; const float* bias; int so;
                if (s == 4) { A = l == 0 ? cb : Ob; W = l == 0 ? Wpw2 : Wo; K = D; alpha = 1.f; bias = l == 0 ? P.b_pw2 : nullptr; so = 3 * l + 2; }
                else { const int j = s == 1 ? 0 : 1; A = act; W = Wout + (size_t)(l * 2 + j) * WOUT_STRIDE; K = FF; alpha = 0.5f; bias = nullptr; so = 3 * l + (j ? 3 : 1); }
                pg8::Gemm g{A, W, M, D, K}; pg8::StaticOrder S; S.init(M, D, G, vb);
                EpiResid E{xb, ssp + (size_t)so * SSP_STRIDE, bias, alpha};
                pg8::gemm_phase<EpiResid, pg8::StaticOrder, true, true>(lds, g, S, E);
            } else if (s == 2) {
                if (l == 0) {
                    pg8::Gemm g{xb, Wpw1, M, 2 * D, D}; pg8::StaticOrder S; S.init(M, 2 * D, G, vb);
                    EpiGLU E{ub, ssp + (size_t)1 * SSP_STRIDE, P.b_pw1};
                    pg8::gemm_phase<EpiGLU, pg8::StaticOrder, true, true>(lds, g, S, E);
                } else {
                    pg8::Gemm g{xb, Wqkv, M, 3 * D, D}; pg8::StaticOrder S; S.init(M, 3 * D, G, vb);
                    EpiQKV E{qb, ssp + (size_t)4 * SSP_STRIDE, qkv_stride};
                    pg8::gemm_phase<EpiQKV, pg8::StaticOrder, true, true>(lds, g, S, E);
                }
            } else {
                if (l == 0) conv_phase(lds, ub, cb, P.w_dw, P.b_dw, P.ln_g, P.ln_b, local ? 128 * xq + rank : vcu, local ? nl : G, local ? 128 * (xq + 1) : M / 32, tid, wave, lane);
                if (l == 1) attn_phase(lds, qb, kb, vb_, Ob, local ? xq * 2048 + rank * NWAVES : vcu * NWAVES, (local ? nl : G) * NWAVES, local ? (xq + 1) * 2048 : NB * NH * (SEQ / 32), wave, lane);
            }
            if (local) xcd_local_barrier(bar); else xcd_barrier(bar);
        }
    }
    {
        const float* ss6 = ssp + (size_t)6 * SSP_STRIDE;
        const bool local = bst[3] != 0u; const int xq = (int)bar.x, rank = (int)bst[2], nl = G / 8;
        const int fn_first = local ? xq * SEQ + rank * NWAVES : vcu * NWAVES, fn_stride = (local ? nl : G) * NWAVES, fn_end = local ? (xq + 1) * SEQ : M;
        f32x4 gv[2][2];
#pragma unroll
        for (int p = 0; p < 2; ++p) { gv[p][0] = *(const f32x4*)(P.final_g + p * 512 + lane * 8); gv[p][1] = *(const f32x4*)(P.final_g + p * 512 + lane * 8 + 4); }
        for (int m = fn_first + wave; m < fn_end; m += fn_stride) {
            const float rs = row_rstd(ss6, m);
#pragma unroll
            for (int p = 0; p < 2; ++p) {
                const u32x4 w = *(const u32x4*)(xb + (size_t)m * D + p * 512 + lane * 8);
                const f32x4 v0 = (f32x4){__uint_as_float(w.x << 16), __uint_as_float(w.x & 0xffff0000u), __uint_as_float(w.y << 16), __uint_as_float(w.y & 0xffff0000u)};
                const f32x4 v1 = (f32x4){__uint_as_float(w.z << 16), __uint_as_float(w.z & 0xffff0000u), __uint_as_float(w.w << 16), __uint_as_float(w.w & 0xffff0000u)};
                float* o = P.out + (size_t)m * D + p * 512 + lane * 8;
                __builtin_nontemporal_store(v0 * rs * gv[p][0], (f32x4*)o); __builtin_nontemporal_store(v1 * rs * gv[p][1], (f32x4*)(o + 4));
            }
        }
    }
}
}

extern "C" void kernel_launch(void* const* d_in, const int* in_sizes, int n_in, void* d_out, int out_size, void* d_ws, size_t ws_size, hipStream_t stream) {
    static int grid = 0;
    if (grid == 0) {
        if (n_in != 15 || in_sizes[0] != mk::M * mk::D || out_size != mk::M * mk::D || ws_size < mk::WS_END) {
            fprintf(stderr, "kernel_launch: unexpected shapes (n_in %d, in0 %d, out %d, ws %zu); nothing launched\n", n_in, n_in > 0 ? in_sizes[0] : -1, out_size, ws_size); grid = -1; return; }
        int dev = 0, cus = 0, per_cu = 0;
        if (hipGetDevice(&dev) != hipSuccess || hipDeviceGetAttribute(&cus, hipDeviceAttributeMultiprocessorCount, dev) != hipSuccess) { grid = -1; return; }
        if (hipFuncSetAttribute((const void*)mk::mk_fwd, hipFuncAttributeMaxDynamicSharedMemorySize, mk::LDS_BYTES) != hipSuccess) { fprintf(stderr, "kernel_launch: hipFuncSetAttribute failed\n"); grid = -1; return; }
        if (hipOccupancyMaxActiveBlocksPerMultiprocessor(&per_cu, (const void*)mk::mk_fwd, mk::NTHREADS, mk::LDS_BYTES) != hipSuccess || per_cu < 1) { fprintf(stderr, "kernel_launch: occupancy query says %d\n", per_cu); per_cu = 1; }
        (void)hipGetLastError();
        grid = cus * per_cu;
    }
    if (grid < 0) return;
    mk::Args a{};
    for (int i = 0; i < 15; ++i) a.in[i] = (const float*)d_in[i];
    a.out = (float*)d_out; a.ws = (unsigned char*)d_ws;
    void* args[] = {&a};
    hipError_t e = hipLaunchCooperativeKernel((const void*)mk::mk_fwd, dim3(grid), dim3(mk::NTHREADS), args, mk::LDS_BYTES, stream);
    if (e != hipSuccess) fprintf(stderr, "kernel_launch: cooperative launch failed: %s (grid %d)\n", hipGetErrorString(e), grid);
}
```

```cpp
#include <hip/hip_runtime.h>
#include <hip/hip_cooperative_groups.h>
#include <cstdio>
#include <cstdint>
namespace cg = cooperative_groups;
namespace pg8 {
#define PG8_LAS __attribute__((address_space(3)))
typedef unsigned short bf16_t;
typedef short bf16x8 __attribute__((ext_vector_type(8)));
typedef float f32x4 __attribute__((ext_vector_type(4)));
typedef unsigned u32x4 __attribute__((ext_vector_type(4)));
constexpr int BM = 256, BK = 64, HALF = 128, HTB = HALF * BK * 2  , STAGE_BYTES = 8 * HTB, NXCD = 8, WGM = 8;

__host__ __device__ __forceinline__ int lds_byte(int r, int c) { const int st = (r >> 4) * 2 + (c >> 5), rr = r & 15, cc = c & 31, ob = rr * 64 + cc * 2; return st * 1024 + (ob ^ (((ob >> 9) & 1) << 5)); }
__host__ __device__ __forceinline__ void stage_rc(int b, int& R, int& C) { const int st = b / 1024, sb = b % 1024, swz = sb ^ (((sb >> 9) & 1) << 5); R = (st >> 1) * 16 + swz / 64; C = (st & 1) * 32 + (swz % 64) / 2; }
__host__ __device__ __forceinline__ int perm32(int rho) { const int n = rho >> 4, i = rho & 15; return 8 * (i >> 2) + 4 * n + (i & 3); }

struct Unit { int pm, pn; };
struct Gemm { const bf16_t* A; const bf16_t* Bt; int M, N, K; };

struct StaticOrder {
    int nM, nN, nwg, G, c;
    __host__ __device__ void init(int M, int N, int G_, int c_) { nM = M / BM; nN = N / BM; nwg = nM * nN; G = G_; c = c_; }
    __host__ __device__ bool next(int i, Unit& u) const {
        const long L = (long)i * G + c; if (L >= nwg) return false;
        int wgid = (int)L; { const int q = nwg / NXCD, r = nwg % NXCD, xcd = wgid % NXCD, off = wgid / NXCD; wgid = (xcd < r ? xcd * (q + 1) : r * (q + 1) + (xcd - r) * q) + off; }
        const int nig = WGM * nN, gid = wgid / nig, fm = gid * WGM, gsz = (nM - fm) < WGM ? (nM - fm) : WGM;
        u.pm = fm + ((wgid % nig) % gsz); u.pn = (wgid % nig) / gsz; return true;
    }
    __device__ __forceinline__ void a_ready(const Unit&) const {}
    __device__ __forceinline__ void done(const Unit&) const {}
};

__device__ __forceinline__ unsigned cvt_pk_bf16(float lo, float hi) { unsigned r; asm volatile("v_cvt_pk_bf16_f32 %0, %1, %2" : "=v"(r) : "v"(lo), "v"(hi)); return r; }
template <class Epi, class Sched, bool ALIGN_EPI = false, bool SP2 = false>
__device__ __forceinline__ void gemm_phase(PG8_LAS unsigned char* lds, const Gemm g, const Sched& S, const Epi& E) {
    int tid_ = threadIdx.x; asm volatile("" : "+v"(tid_));
    const int tid = tid_, wid = __builtin_amdgcn_readfirstlane(tid >> 6), lane = tid & 63, wr = wid >> 2, wc = wid & 3, fr = lane & 15, fq = lane >> 4;
    const int K = g.K, nt = K / BK;
    unsigned voffA[2], voffB[2];
#pragma unroll
    for (int i = 0; i < 2; ++i) { int R, C; stage_rc(tid * 16 + i * 8192, R, C); const int Rb = Epi::PERM ? ((R & ~31) + perm32(R & 31)) : R;
        voffA[i] = (unsigned)(R * K + C) * 2u; voffB[i] = (unsigned)(Rb * K + C) * 2u; }
    const size_t kstep = (size_t)(BK * 2);
    const size_t hstep = (size_t)HALF * K * 2;
    const size_t tstep = 2 * hstep;
    const unsigned ldsw = (unsigned)wid * 1024u;
    const int aoff = lds_byte(wr * 64 + fr, fq * 8), boff = lds_byte(wc * 32 + fr, fq * 8);
#define PG8_SA(b, h) (((b) * 2 + (h)) * HTB)
#define PG8_SB(b, h) ((4 + (b) * 2 + (h)) * HTB)
#define PG8_STAGE(bufoff, gbase, voff) do { _Pragma("unroll") for (int _i = 0; _i < 2; ++_i) \
        __builtin_amdgcn_global_load_lds((const unsigned*)((const char*)(gbase) + (voff)[_i]), (PG8_LAS unsigned*)(lds + (bufoff) + ldsw + _i * 8192), 16, 0, 0); } while (0)
#define PG8_LDA(dst, b, h) do { _Pragma("unroll") for (int m = 0; m < 4; ++m) _Pragma("unroll") for (int k = 0; k < 2; ++k) dst[m][k] = *(const PG8_LAS bf16x8*)(lds + PG8_SA(b, h) + aoff + m * 2048 + k * 1024); } while (0)
#define PG8_LDB(dst, b, h) do { _Pragma("unroll") for (int n = 0; n < 2; ++n) _Pragma("unroll") for (int k = 0; k < 2; ++k) dst[n][k] = *(const PG8_LAS bf16x8*)(lds + PG8_SB(b, h) + boff + n * 2048 + k * 1024); } while (0)
#define PG8_MMA(ai, bj, At, Bt) do { __builtin_amdgcn_s_setprio(1); _Pragma("unroll") for (int m = 0; m < 4; ++m) _Pragma("unroll") for (int n = 0; n < 2; ++n) _Pragma("unroll") for (int k = 0; k < 2; ++k) \
        acc[ai][bj][m][n] = __builtin_amdgcn_mfma_f32_16x16x32_bf16(Bt[n][k], At[m][k], acc[ai][bj][m][n], 0, 0, 0); __builtin_amdgcn_s_setprio(0); } while (0)
#define PG8_WAIT_V(n) asm volatile("s_waitcnt vmcnt(" #n ")" ::: "memory")
#define PG8_WAIT_L(n) asm volatile("s_waitcnt lgkmcnt(" #n ")" ::: "memory")
#define PG8_BAR __builtin_amdgcn_s_barrier()
#define PG8_SCHED __builtin_amdgcn_sched_barrier(0)
    Unit cur, nxt; int ui = 0;
    if (!S.next(0, cur)) return;
    f32x4 acc[2][2][4][2];
#pragma unroll
    for (int a = 0; a < 2; ++a)
#pragma unroll
        for (int b = 0; b < 2; ++b)
#pragma unroll
            for (int m = 0; m < 4; ++m)
#pragma unroll
                for (int n = 0; n < 2; ++n) acc[a][b][m][n] = (f32x4){0.f, 0.f, 0.f, 0.f};
    bf16x8 At[4][2], B0[2][2], B1[2][2];
    const char* cA = (const char*)g.A + (size_t)cur.pm * tstep; const char* cB = (const char*)g.Bt + (size_t)cur.pn * tstep;
    S.a_ready(cur);
    E.rs_first(cur, lds, tid);
    if constexpr (SP2) {
        PG8_STAGE(PG8_SB(0, 0), cB, voffB); PG8_STAGE(PG8_SB(0, 1), cB + hstep, voffB); PG8_STAGE(PG8_SA(0, 0), cA, voffA); PG8_STAGE(PG8_SA(0, 1), cA + hstep, voffA);
        if (wr == 1) PG8_BAR;
        PG8_WAIT_V(2); PG8_BAR;
        PG8_STAGE(PG8_SB(1, 0), cB + kstep, voffB); PG8_STAGE(PG8_SA(1, 0), cA + kstep, voffA); PG8_STAGE(PG8_SB(1, 1), cB + hstep + kstep, voffB);
        PG8_WAIT_V(6); PG8_BAR;
    } else {
        PG8_STAGE(PG8_SB(0, 0), cB, voffB); PG8_STAGE(PG8_SA(0, 0), cA, voffA); PG8_STAGE(PG8_SB(0, 1), cB + hstep, voffB); PG8_STAGE(PG8_SA(0, 1), cA + hstep, voffA);
        if (wr == 1) PG8_BAR;
        PG8_WAIT_V(4); PG8_BAR;
        PG8_STAGE(PG8_SB(1, 0), cB + kstep, voffB); PG8_STAGE(PG8_SA(1, 0), cA + kstep, voffA); PG8_STAGE(PG8_SB(1, 1), cB + hstep + kstep, voffB);
        PG8_WAIT_V(6); PG8_BAR;
    }
    for (;;) {
        const bool has_next = S.next(ui + 1, nxt);
        const char* nA = has_next ? (const char*)g.A + (size_t)nxt.pm * tstep : cA; const char* nB = has_next ? (const char*)g.Bt + (size_t)nxt.pn * tstep : cB;
        for (int t = 0; t < nt; t += 2) {
            const bool last = (t == nt - 2);
            const char* a1 = cA + (size_t)(t + 1) * kstep;
            const char* a2 = last ? nA : cA + (size_t)(t + 2) * kstep; const char* b2 = last ? nB : cB + (size_t)(t + 2) * kstep;
            const char* a3 = a2 + kstep; const char* b3 = b2 + kstep;
            if (last && has_next) S.a_ready(nxt);
            if constexpr (SP2) {
            const int relax = __builtin_amdgcn_readfirstlane((t == 0 && ui > 0) ? 1 : 0);
            PG8_LDB(B0, 0, 0); PG8_LDB(B1, 0, 1); PG8_SCHED; PG8_LDA(At, 0, 0); PG8_STAGE(PG8_SA(1, 1), a1 + hstep, voffA);
            asm volatile("s_cmp_lg_u32 %0, 0\n\ts_cbranch_scc1 .Lrelax%=\n\ts_waitcnt vmcnt(8)\n.Lrelax%=:\n\ts_waitcnt vmcnt(%1)" :: "s"(relax), "n"(8 + Epi::NST) : "memory", "scc");
            PG8_WAIT_L(0); PG8_BAR; PG8_MMA(0, 0, At, B0); PG8_MMA(0, 1, At, B1); PG8_BAR; PG8_SCHED;
            PG8_LDA(At, 0, 1); PG8_STAGE(PG8_SB(0, 0), b2, voffB); PG8_STAGE(PG8_SB(0, 1), b2 + hstep, voffB); PG8_STAGE(PG8_SA(0, 0), a2, voffA);
            asm volatile("s_cmp_lg_u32 %0, 0\n\ts_cbranch_scc1 .Lrelax%=\n\ts_waitcnt vmcnt(8)\n.Lrelax%=:\n\ts_waitcnt vmcnt(%1)" :: "s"(relax), "n"(8 + Epi::NST) : "memory", "scc");
            PG8_WAIT_L(0); PG8_BAR; PG8_MMA(1, 0, At, B0); PG8_MMA(1, 1, At, B1); PG8_BAR; PG8_SCHED;
            PG8_LDB(B0, 1, 0); PG8_LDB(B1, 1, 1); PG8_SCHED; PG8_LDA(At, 1, 0); PG8_STAGE(PG8_SA(0, 1), a2 + hstep, voffA);
            PG8_WAIT_V(8); PG8_WAIT_L(0); PG8_BAR; PG8_MMA(0, 0, At, B0); PG8_MMA(0, 1, At, B1); PG8_BAR; PG8_SCHED;
            PG8_LDA(At, 1, 1); PG8_STAGE(PG8_SB(1, 0), b3, voffB); PG8_STAGE(PG8_SB(1, 1), b3 + hstep, voffB); PG8_STAGE(PG8_SA(1, 0), a3, voffA);
            PG8_WAIT_V(8); PG8_WAIT_L(0); PG8_BAR; PG8_MMA(1, 0, At, B0); PG8_MMA(1, 1, At, B1); PG8_BAR; PG8_SCHED;
            } else {
            PG8_LDB(B0, 0, 0); PG8_SCHED; PG8_LDA(At, 0, 0); PG8_STAGE(PG8_SA(1, 1), a1 + hstep, voffA);
            PG8_WAIT_L(8); PG8_BAR; PG8_WAIT_L(0); PG8_MMA(0, 0, At, B0); PG8_BAR; PG8_SCHED;
            PG8_LDB(B1, 0, 1); PG8_STAGE(PG8_SB(0, 0), b2, voffB);
            PG8_BAR; PG8_WAIT_L(0); PG8_MMA(0, 1, At, B1); PG8_BAR;
            PG8_LDA(At, 0, 1); PG8_STAGE(PG8_SA(0, 0), a2, voffA);
            PG8_BAR; PG8_WAIT_L(0); PG8_MMA(1, 0, At, B0); PG8_BAR; PG8_SCHED;
            PG8_STAGE(PG8_SB(0, 1), b2 + hstep, voffB);
            PG8_WAIT_V(6); PG8_BAR; PG8_MMA(1, 1, At, B1); PG8_BAR;
            PG8_LDB(B0, 1, 0); PG8_SCHED; PG8_LDA(At, 1, 0); PG8_STAGE(PG8_SA(0, 1), a2 + hstep, voffA);
            PG8_WAIT_L(8); PG8_BAR; PG8_WAIT_L(0); PG8_MMA(0, 0, At, B0); PG8_BAR; PG8_SCHED;
            PG8_LDB(B1, 1, 1); PG8_STAGE(PG8_SB(1, 0), b3, voffB);
            PG8_BAR; PG8_WAIT_L(0); PG8_MMA(0, 1, At, B1); PG8_BAR;
            PG8_LDA(At, 1, 1); PG8_STAGE(PG8_SA(1, 0), a3, voffA);
            PG8_BAR; PG8_WAIT_L(0); PG8_MMA(1, 0, At, B0); PG8_BAR; PG8_SCHED;
            PG8_STAGE(PG8_SB(1, 1), b3 + hstep, voffB);
            PG8_WAIT_V(6); PG8_BAR; PG8_MMA(1, 1, At, B1); PG8_BAR;
            }
        }
        if constexpr (ALIGN_EPI) { if (wr == 0) PG8_BAR; }
        if constexpr (!Epi::AFTER_DRAIN) { E(acc, cur, wr, wc, fr, fq, lds, tid, ui, nxt, has_next); S.done(cur); }
        if (!has_next) break;
#pragma unroll
        for (int a = 0; a < 2; ++a)
#pragma unroll
            for (int b = 0; b < 2; ++b)
#pragma unroll
                for (int m = 0; m < 4; ++m)
#pragma unroll
                    for (int n = 0; n < 2; ++n) acc[a][b][m][n] = (f32x4){0.f, 0.f, 0.f, 0.f};
        cur = nxt; cA = nA; cB = nB; ++ui;
        if constexpr (ALIGN_EPI) { if (wr == 1) PG8_BAR; }
    }
    PG8_WAIT_V(0);
    if constexpr (!ALIGN_EPI) { if (wr == 0) PG8_BAR; }
    PG8_BAR;
    if constexpr (Epi::AFTER_DRAIN) { E.fused(acc, cur, wr, wc, fr, fq, lds, wid, lane); S.done(cur); }
#undef PG8_SA
#undef PG8_SB
#undef PG8_STAGE
#undef PG8_LDA
#undef PG8_LDB
#undef PG8_MMA
#undef PG8_WAIT_V
#undef PG8_WAIT_L
#undef PG8_BAR
#undef PG8_SCHED
}
}

namespace mk {
using pg8::bf16_t; using pg8::bf16x8; using pg8::f32x4; using pg8::u32x4; using pg8::Unit; using pg8::cvt_pk_bf16;
#define LAS __attribute__((address_space(3)))
typedef float f32x16 __attribute__((ext_vector_type(16)));
typedef short v4i16_t __attribute__((ext_vector_type(4)));
#define XB_TMO      128
#define XB_XCNT(j)  (256  + 64 * (j))
#define XB_XSUB(j)  (1280 + 64 * (j))
#define XB_XGEN(j)  (2304 + 64 * (j))
#define XB_TOP      3328
#define XB_TOPGEN   3392
#define XCD_BAR_WORDS 3456
#define XB_SPIN_CAP (1u << 18)

__device__ __forceinline__ unsigned xb_ld(unsigned* p)              { return __hip_atomic_load(p, __ATOMIC_RELAXED, __HIP_MEMORY_SCOPE_AGENT); }
__device__ __forceinline__ unsigned xb_add(unsigned* p, unsigned v) { return __hip_atomic_fetch_add(p, v, __ATOMIC_RELAXED, __HIP_MEMORY_SCOPE_AGENT); }
__device__ __forceinline__ unsigned xb_xcc_id() { return (unsigned)__builtin_amdgcn_s_getreg((3 << 11) | 20) & 0xFu; }
#define XB_SPIN(cond, bar) do { unsigned _sp = 0; while (cond) { __builtin_amdgcn_s_sleep(1); \
    if ((++_sp & 255u) == 0u) { if (xb_ld(&(bar)[XB_TMO])) break; if (_sp > XB_SPIN_CAP) { atomicAdd(&(bar)[XB_TMO], 1u); break; } } } } while (0)

struct XcdBarrier {
    unsigned* bar; unsigned x;
    volatile LAS unsigned* st;
};

__device__ __forceinline__ XcdBarrier xcd_barrier_post(unsigned* bar, volatile LAS unsigned* st) {
    XcdBarrier b; b.bar = bar; b.x = xb_xcc_id(); b.st = st;
    if (threadIdx.x == 0) (void)xb_add(&bar[XB_XCNT(b.x)], 1u);
    return b;
}
__device__ __forceinline__ void xcd_barrier_complete(unsigned* bar, unsigned x, unsigned& nloc, unsigned& nx) {
    const unsigned G = gridDim.x * gridDim.y * gridDim.z;
    unsigned sum, cnt, mine, sp = 0u;
    for (;;) {
        sum = 0u; cnt = 0u; mine = 0u;
#pragma unroll
        for (unsigned j = 0; j < 16; ++j) { const unsigned c = xb_ld(&bar[XB_XCNT(j)]); sum += c; cnt += (c > 0u) ? 1u : 0u; mine = (j == x) ? c : mine; }
        if (sum == G) break;
        __builtin_amdgcn_s_sleep(1);
        if ((++sp & 255u) == 0u) { if (xb_ld(&bar[XB_TMO])) break; if (sp > XB_SPIN_CAP) { atomicAdd(&bar[XB_TMO], 1u); break; } }
    }
    nloc = mine > 0u ? mine : 1u; nx = cnt > 0u ? cnt : 1u;
}

__device__ __forceinline__ void xcd_barrier(const XcdBarrier& b) {
    asm volatile("s_waitcnt vmcnt(0)" ::: "memory");
    __syncthreads();
    if (threadIdx.x == 0) {
        unsigned* bar = b.bar;
        __builtin_amdgcn_s_waitcnt(0);
        unsigned nloc = b.st[0], nx = b.st[1];
        if (nloc == 0u) { xcd_barrier_complete(bar, b.x, nloc, nx); b.st[0] = nloc; b.st[1] = nx; }
        const unsigned old = xb_add(&bar[XB_XSUB(b.x)], 1u);
        const unsigned gen = old / nloc;
        if (old + 1u == (gen + 1u) * nloc) {
            __builtin_amdgcn_fence(__ATOMIC_RELEASE, "agent");
            asm volatile("s_waitcnt vmcnt(0)" ::: "memory");
            const unsigned og = xb_add(&bar[XB_TOP], 1u);
            const unsigned tg = og / nx;
            if (og + 1u == (tg + 1u) * nx) xb_add(&bar[XB_TOPGEN], 1u);
            else XB_SPIN(xb_ld(&bar[XB_TOPGEN]) == tg, bar);
            __builtin_amdgcn_fence(__ATOMIC_ACQUIRE, "agent");
            xb_add(&bar[XB_XGEN(b.x)], 1u);
            asm volatile("s_waitcnt vmcnt(0)" ::: "memory");
        } else {
            XB_SPIN(xb_ld(&bar[XB_XGEN(b.x)]) == gen, bar);
            __builtin_amdgcn_fence(__ATOMIC_ACQUIRE, "agent");
            asm volatile("s_waitcnt vmcnt(0)" ::: "memory");
        }
    }
    __syncthreads();
}

#define XB_LSUB(j)  (3456 + 64 * (j))
#define XB_LGEN(j)  (3968 + 64 * (j))
#define XB_ALL_WORDS 4480
__device__ __forceinline__ void xcd_local_barrier(const XcdBarrier& b) {
    asm volatile("s_waitcnt vmcnt(0)" ::: "memory");
    __syncthreads();
    if (threadIdx.x == 0) {
        unsigned* bar = b.bar;
        __builtin_amdgcn_s_waitcnt(0);
        const unsigned nloc = b.st[0];
        const unsigned old = xb_add(&bar[XB_LSUB(b.x)], 1u);
        const unsigned gen = old / nloc;
        if (old + 1u == (gen + 1u) * nloc) xb_add(&bar[XB_LGEN(b.x)], 1u);
        else XB_SPIN(xb_ld(&bar[XB_LGEN(b.x)]) == gen, bar);
        __builtin_amdgcn_fence(__ATOMIC_ACQUIRE, "agent");
        asm volatile("s_waitcnt vmcnt(0)" ::: "memory");
    }
    __syncthreads();
}

constexpr int M = 32768, D = 1024, FF = 2816, SEQ = 4096, NB = 8, NH = 16, HD = 64, CW = 31;
constexpr float RMS_EPS = 1e-6f, LN_EPS = 1e-5f, LOG2E = 1.4426950408889634f;
constexpr int NWAVES = 8, NTHREADS = 512;
constexpr int LDS_BYTES = 147456;

constexpr size_t MiB = 1u << 20;
constexpr size_t WS_SSP = 0;
constexpr size_t SSP_STRIDE = (size_t)M * 16;
constexpr size_t WS_BAR = 15 * MiB;
constexpr size_t WS_WIN = 16 * MiB;
constexpr size_t WIN_STRIDE = (size_t)2 * FF * D;
constexpr size_t WS_WOUT = WS_WIN + 4 * WIN_STRIDE * 2;
constexpr size_t WOUT_STRIDE = (size_t)D * FF;
constexpr size_t WS_WPW1 = WS_WOUT + 4 * WOUT_STRIDE * 2;
constexpr size_t WS_WPW2 = WS_WPW1 + (size_t)2 * D * D * 2;
constexpr size_t WS_WQKV = WS_WPW2 + (size_t)D * D * 2;
constexpr size_t WS_WO = WS_WQKV + (size_t)3 * D * D * 2;
constexpr size_t WS_XB = 98 * MiB;
constexpr size_t WS_R = 162 * MiB;
constexpr size_t WS_O = 354 * MiB;
constexpr size_t WS_END = 418 * MiB;
static_assert(WS_WO + (size_t)D * D * 2 <= WS_XB, "ws map");
static_assert((size_t)M * FF * 2 <= 192 * MiB, "ws map");

__device__ __forceinline__ float sigm(float x) { return __builtin_amdgcn_rcpf(1.f + __builtin_amdgcn_exp2f(-LOG2E * x)); }
__device__ __forceinline__ float wave_sum(float v) {
#pragma unroll
    for (int o = 1; o < 64; o <<= 1) v += __shfl_xor(v, o);
    return v;
}
__device__ __forceinline__ float row_rstd(const float* ssp, int row) {
    const f32x4* p = (const f32x4*)(ssp + (size_t)row * 16);
    f32x4 a = p[0], b = p[1], c = p[2], d = p[3]; a = (a + b) + (c + d);
    return rsqrtf(((a.x + a.y) + (a.z + a.w)) * (1.f / D) + RMS_EPS);
}

constexpr int RS_LDS_OFF = 131072;
__device__ __forceinline__ void rs_issue(const float* ssp, const Unit& u, int tid, f32x4& a, f32x4& b) { const float* p = ssp + (size_t)(u.pm * 256 + (tid >> 1)) * 16 + 8 * (tid & 1); a = *(const f32x4*)p; b = *(const f32x4*)(p + 4); }
__device__ __forceinline__ void rs_finish(LAS unsigned char* lds, int buf, int tid, const f32x4& a, const f32x4& b) {
    float t = ((a.x + a.y) + (a.z + a.w)) + ((b.x + b.y) + (b.z + b.w)); t += __shfl_xor(t, 1);
    if (!(tid & 1)) ((LAS float*)(lds + RS_LDS_OFF))[buf * 256 + (tid >> 1)] = rsqrtf(t * (1.f / D) + RMS_EPS);
}
__device__ __forceinline__ void rs_read(LAS unsigned char* lds, int buf, int wr, int fr, float (&rs)[2][4]) {
    const LAS float* t = (const LAS float*)(lds + RS_LDS_OFF) + buf * 256 + wr * 64 + fr;
#pragma unroll
    for (int ai = 0; ai < 2; ++ai)
#pragma unroll
        for (int m = 0; m < 4; ++m) rs[ai][m] = t[ai * 128 + m * 16];
}
struct EpiSwiGLU {
    static constexpr bool PERM = true, AFTER_DRAIN = false; static constexpr int NST = 8;
    bf16_t* O; const float* ssp;
    __device__ __forceinline__ void rs_first(const Unit& u, LAS unsigned char* lds, int tid) const { f32x4 a, b; rs_issue(ssp, u, tid, a, b); rs_finish(lds, 0, tid, a, b); }
    __device__ __forceinline__ void operator()(const f32x4 (&acc)[2][2][4][2], const Unit& u, int wr, int wc, int fr, int fq, LAS unsigned char* lds, int tid, int ui, const Unit& nxt, bool has_next) const {
        f32x4 na, nb; if (has_next) rs_issue(ssp, nxt, tid, na, nb);
        const int row0 = u.pm * 256 + wr * 64 + fr, col0 = u.pn * 128 + wc * 32 + 8 * fq;
        float rsv[2][4]; rs_read(lds, ui & 1, wr, fr, rsv);
#pragma unroll
        for (int ai = 0; ai < 2; ++ai)
#pragma unroll
            for (int m = 0; m < 4; ++m) {
                const int row = row0 + ai * 128 + m * 16;
                const float rs = rsv[ai][m];
                typedef float f32x2 __attribute__((ext_vector_type(2)));
                const f32x2 rs2 = (f32x2){rs, rs}, nrs2 = (f32x2){-LOG2E * rs, -LOG2E * rs};
                unsigned wv[4];
#pragma unroll
                for (int n = 0; n < 2; ++n)
#pragma unroll
                    for (int hp = 0; hp < 2; ++hp) {
                        const f32x2 ag = (f32x2){acc[ai][0][m][n][2 * hp], acc[ai][0][m][n][2 * hp + 1]}, au = (f32x2){acc[ai][1][m][n][2 * hp], acc[ai][1][m][n][2 * hp + 1]};
                        const f32x2 g = ag * rs2, up = au * rs2, ne = ag * nrs2;
                        const f32x2 dd = (f32x2){__builtin_amdgcn_exp2f(ne.x), __builtin_amdgcn_exp2f(ne.y)} + 1.0f;
                        const f32x2 rr = (f32x2){__builtin_amdgcn_rcpf(dd.x), __builtin_amdgcn_rcpf(dd.y)};
                        const f32x2 oo = (g * rr) * up;
                        wv[n * 2 + hp] = cvt_pk_bf16(oo.x, oo.y);
                    }
                u32x4 w; w.x = wv[0]; w.y = wv[1]; w.z = wv[2]; w.w = wv[3];
                __builtin_nontemporal_store(w, (u32x4*)(O + (size_t)row * FF + col0));
            }
        if (has_next) rs_finish(lds, (ui + 1) & 1, tid, na, nb);
    }
};
struct EpiGLU {
    static constexpr bool PERM = true, AFTER_DRAIN = false; static constexpr int NST = 8;
    bf16_t* O; const float* ssp; const float* bias;
    __device__ __forceinline__ void rs_first(const Unit& u, LAS unsigned char* lds, int tid) const { f32x4 a, b; rs_issue(ssp, u, tid, a, b); rs_finish(lds, 0, tid, a, b); }
    __device__ __forceinline__ void operator()(const f32x4 (&acc)[2][2][4][2], const Unit& u, int wr, int wc, int fr, int fq, LAS unsigned char* lds, int tid, int ui, const Unit& nxt, bool has_next) const {
        f32x4 na, nb; if (has_next) rs_issue(ssp, nxt, tid, na, nb);
        const int row0 = u.pm * 256 + wr * 64 + fr, col0 = u.pn * 128 + wc * 32 + 8 * fq;
        f32x4 bv[2][2];
#pragma unroll
        for (int bj = 0; bj < 2; ++bj)
#pragma unroll
            for (int n = 0; n < 2; ++n) bv[bj][n] = *(const f32x4*)(bias + bj * D + col0 + 4 * n);
        float rsv[2][4]; rs_read(lds, ui & 1, wr, fr, rsv);
#pragma unroll
        for (int ai = 0; ai < 2; ++ai)
#pragma unroll
            for (int m = 0; m < 4; ++m) {
                const int row = row0 + ai * 128 + m * 16;
                const float rs = rsv[ai][m];
                float o[8];
#pragma unroll
                for (int n = 0; n < 2; ++n)
#pragma unroll
                    for (int e = 0; e < 4; ++e) { const float v = acc[ai][0][m][n][e] * rs + bv[0][n][e], g = acc[ai][1][m][n][e] * rs + bv[1][n][e]; o[n * 4 + e] = v * sigm(g); }
                u32x4 w; w.x = cvt_pk_bf16(o[0], o[1]); w.y = cvt_pk_bf16(o[2], o[3]); w.z = cvt_pk_bf16(o[4], o[5]); w.w = cvt_pk_bf16(o[6], o[7]);
                *(u32x4*)(O + (size_t)row * D + col0) = w;
            }
        if (has_next) rs_finish(lds, (ui + 1) & 1, tid, na, nb);
    }
};
struct EpiQKV {
    static constexpr bool PERM = true, AFTER_DRAIN = false; static constexpr int NST = 16;
    bf16_t* O; const float* ssp; size_t tstride;
    __device__ __forceinline__ void rs_first(const Unit& u, LAS unsigned char* lds, int tid) const { f32x4 a, b; rs_issue(ssp, u, tid, a, b); rs_finish(lds, 0, tid, a, b); }
    __device__ __forceinline__ void operator()(const f32x4 (&acc)[2][2][4][2], const Unit& u, int wr, int wc, int fr, int fq, LAS unsigned char* lds, int tid, int ui, const Unit& nxt, bool has_next) const {
        f32x4 na, nb; if (has_next) rs_issue(ssp, nxt, tid, na, nb);
        const int row0 = u.pm * 256 + wr * 64 + fr; const int t = u.pn >> 2;
        bf16_t* base = O + (size_t)t * tstride; const int col0 = (u.pn & 3) * 256 + wc * 32 + 8 * fq;
        float rsv[2][4]; rs_read(lds, ui & 1, wr, fr, rsv);
#pragma unroll
        for (int ai = 0; ai < 2; ++ai)
#pragma unroll
            for (int m = 0; m < 4; ++m) {
                const int row = row0 + ai * 128 + m * 16;
                const float rs = rsv[ai][m];
#pragma unroll
                for (int bj = 0; bj < 2; ++bj) {
                    const f32x4 v0 = acc[ai][bj][m][0] * rs, v1 = acc[ai][bj][m][1] * rs;
                    u32x4 w; w.x = cvt_pk_bf16(v0[0], v0[1]); w.y = cvt_pk_bf16(v0[2], v0[3]); w.z = cvt_pk_bf16(v1[0], v1[1]); w.w = cvt_pk_bf16(v1[2], v1[3]);
                    *(u32x4*)(base + (size_t)row * D + col0 + bj * 128) = w;
                }
            }
        if (has_next) rs_finish(lds, (ui + 1) & 1, tid, na, nb);
    }
};
struct EpiResid {
    static constexpr bool PERM = true, AFTER_DRAIN = false; static constexpr int NST = 24;
    bf16_t* xb; float* ssp; const float* bias; float alpha;
    __device__ __forceinline__ void rs_first(const Unit&, LAS unsigned char*, int) const {}
    __device__ __forceinline__ void operator()(const f32x4 (&acc)[2][2][4][2], const Unit& u, int wr, int wc, int fr, int fq, LAS unsigned char* lds, int tid, int ui, const Unit& nxt, bool has_next) const {
        const int row0 = u.pm * 256 + wr * 64 + fr, col0 = u.pn * 256 + wc * 32 + 8 * fq;
        f32x4 bv[2][2];
#pragma unroll
        for (int bj = 0; bj < 2; ++bj)
#pragma unroll
            for (int n = 0; n < 2; ++n) bv[bj][n] = bias ? *(const f32x4*)(bias + col0 + bj * 128 + 4 * n) : (f32x4){0.f, 0.f, 0.f, 0.f};
#pragma unroll
        for (int ai = 0; ai < 2; ++ai) {
            u32x4 xr[4][2];
#pragma unroll
            for (int m = 0; m < 4; ++m)
#pragma unroll
                for (int bj = 0; bj < 2; ++bj) xr[m][bj] = *(const u32x4*)(xb + (size_t)(row0 + ai * 128 + m * 16) * D + col0 + bj * 128);
#pragma unroll
            for (int m = 0; m < 4; ++m) {
                const int row = row0 + ai * 128 + m * 16; const size_t off = (size_t)row * D + col0;
                typedef float f32x2 __attribute__((ext_vector_type(2)));
                f32x2 sq2 = (f32x2){0.f, 0.f};
#pragma unroll
                for (int bj = 0; bj < 2; ++bj) {
                    f32x2 v[4];
                    const u32x4 w0 = xr[m][bj];
#pragma unroll
                    for (int i = 0; i < 4; ++i) v[i] = (f32x2){__uint_as_float(w0[i] << 16), __uint_as_float(w0[i] & 0xffff0000u)};
                    const f32x2 al2 = (f32x2){alpha, alpha};
                    unsigned wv[4];
#pragma unroll
                    for (int i = 0; i < 4; ++i) {
                        const f32x4 av = acc[ai][bj][m][i >> 1], bb = bv[bj][i >> 1];
                        const f32x2 a2 = (i & 1) ? (f32x2){av.z, av.w} : (f32x2){av.x, av.y}, b2 = (i & 1) ? (f32x2){bb.z, bb.w} : (f32x2){bb.x, bb.y};
                        v[i] = __builtin_elementwise_fma(a2, al2, v[i]) + b2;
                        sq2 = __builtin_elementwise_fma(v[i], v[i], sq2);
                        wv[i] = cvt_pk_bf16(v[i].x, v[i].y);
                    }
                    u32x4 w; w.x = wv[0]; w.y = wv[1]; w.z = wv[2]; w.w = wv[3];
                    *(u32x4*)(xb + off + bj * 128) = w;
                }
                float sq = sq2.x + sq2.y;
                sq += __shfl_xor(sq, 16); sq += __shfl_xor(sq, 32);
                if (fq == 0) ssp[(size_t)row * 16 + u.pn * 4 + wc] = sq;
            }
            asm volatile("" ::: "memory");
        }
    }
};

__device__ __forceinline__ void transpose_item(const float* W, int K, int N, const float* g, bf16_t* WT, int glu_h, LAS float* scr, int item, int lane) {
    const int nblk = N / 64, kb = item / nblk, nb = item % nblk, k0 = 64 * kb, n0 = 64 * nb;
    const int lr = lane >> 4, c4 = lane & 15;
    f32x4 v[16];
#pragma unroll
    for (int i = 0; i < 16; ++i) v[i] = __builtin_nontemporal_load((const f32x4*)(W + (size_t)(k0 + 4 * i + lr) * N + n0 + 4 * c4));
    if (g) {
#pragma unroll
        for (int i = 0; i < 16; ++i) v[i] = v[i] * g[k0 + 4 * i + lr];
    }
#pragma unroll
    for (int i = 0; i < 16; ++i) { LAS float* d = scr + (4 * i + lr) * 65 + 4 * c4; d[0] = v[i].x; d[1] = v[i].y; d[2] = v[i].z; d[3] = v[i].w; }
    asm volatile("s_waitcnt lgkmcnt(0)" ::: "memory");
    int drow0 = n0;
    if (glu_h) { const int up = n0 >= glu_h, c = up ? n0 - glu_h : n0; drow0 = (c >> 7) * 256 + up * 128 + (c & 127); }
    const int c = lane & 7;
#pragma unroll
    for (int j = 0; j < 8; ++j) { const int n = (lane >> 3) + 8 * j; const LAS float* p = scr + (8 * c) * 65 + n;
        u32x4 o; o.x = cvt_pk_bf16(p[0 * 65], p[1 * 65]); o.y = cvt_pk_bf16(p[2 * 65], p[3 * 65]); o.z = cvt_pk_bf16(p[4 * 65], p[5 * 65]); o.w = cvt_pk_bf16(p[6 * 65], p[7 * 65]);
        *(u32x4*)(WT + (size_t)(drow0 + n) * K + k0 + 8 * c) = o; }
    asm volatile("s_waitcnt lgkmcnt(0)" ::: "memory");
}

struct Ptrs {
    const float *x, *norm_g, *final_g, *ffn_w_in, *ffn_w_out, *w_pw1, *b_pw1, *w_dw, *b_dw, *ln_g, *ln_b, *w_pw2, *b_pw2, *w_qkv, *w_o;
    float* out; unsigned char* ws;
};

__device__ __forceinline__ void prologue(const Ptrs& P, LAS unsigned char* lds, int vcu, int G, int wave, int lane) {
    LAS float* scr = (LAS float*)(lds + wave * 18432);
    const int gw = vcu * NWAVES + wave, NGW = G * NWAVES;
    constexpr int I_IN = (D / 64) * (2 * FF / 64), I_OUT = (FF / 64) * (D / 64), I_PW1 = (D / 64) * (2 * D / 64), I_SQ = (D / 64) * (D / 64), I_QKV = (D / 64) * (3 * D / 64);
    constexpr int NITEMS = 4 * I_IN + 4 * I_OUT + I_PW1 + I_SQ + I_QKV + I_SQ;
    bf16_t* ws16 = (bf16_t*)P.ws;
    for (int it = gw; it < NITEMS; it += NGW) {
        int r = it; const float* W; const float* g = nullptr; bf16_t* WT; int K = D, N = D, glu = 0;
        if (r < 4 * I_IN) { const int idx = r / I_IN, l = idx >> 1, j = idx & 1; r -= idx * I_IN;
            W = P.ffn_w_in + (size_t)idx * D * 2 * FF; N = 2 * FF; g = P.norm_g + (l * 3 + (j ? 2 : 0)) * D; WT = (bf16_t*)(P.ws + WS_WIN) + idx * WIN_STRIDE; glu = FF; }
        else if ((r -= 4 * I_IN) < 4 * I_OUT) { const int idx = r / I_OUT; r -= idx * I_OUT;
            W = P.ffn_w_out + (size_t)idx * FF * D; K = FF; WT = (bf16_t*)(P.ws + WS_WOUT) + idx * WOUT_STRIDE; }
        else if ((r -= 4 * I_OUT) < I_PW1) { W = P.w_pw1; N = 2 * D; g = P.norm_g + 1 * D; WT = (bf16_t*)(P.ws + WS_WPW1); glu = D; }
        else if ((r -= I_PW1) < I_SQ) { W = P.w_pw2; WT = (bf16_t*)(P.ws + WS_WPW2); }
        else if ((r -= I_SQ) < I_QKV) { W = P.w_qkv; N = 3 * D; g = P.norm_g + 4 * D; WT = (bf16_t*)(P.ws + WS_WQKV); }
        else { r -= I_QKV; W = P.w_o; WT = (bf16_t*)(P.ws + WS_WO); }
        transpose_item(W, K, N, g, WT, glu, scr, r, lane);
    }
    (void)ws16;
    bf16_t* xb = (bf16_t*)(P.ws + WS_XB); float* ssp0 = (float*)(P.ws + WS_SSP);
    for (int m0 = gw; m0 < M; m0 += 2 * NGW) {
        f32x4 v[2][4]; float sq[2];
#pragma unroll
        for (int t = 0; t < 2; ++t) { const f32x4* xr = (const f32x4*)(P.x + (size_t)((t && m0 + NGW >= M) ? m0 : m0 + t * NGW) * D) + lane;
#pragma unroll
            for (int j = 0; j < 4; ++j) v[t][j] = __builtin_nontemporal_load(xr + 64 * j); }
#pragma unroll
        for (int t = 0; t < 2; ++t) { float s_ = 0.f;
#pragma unroll
            for (int j = 0; j < 4; ++j) s_ += (v[t][j].x * v[t][j].x + v[t][j].y * v[t][j].y) + (v[t][j].z * v[t][j].z + v[t][j].w * v[t][j].w);
            sq[t] = wave_sum(s_); }
#pragma unroll
        for (int t = 0; t < 2; ++t) { const int m = (t && m0 + NGW >= M) ? m0 : m0 + t * NGW;
            unsigned long long* o8 = (unsigned long long*)(xb + (size_t)m * D) + lane;
#pragma unroll
            for (int j = 0; j < 4; ++j) o8[64 * j] = (unsigned long long)cvt_pk_bf16(v[t][j].x, v[t][j].y) | ((unsigned long long)cvt_pk_bf16(v[t][j].z, v[t][j].w) << 32);
            if (lane < 16) ssp0[(size_t)m * 16 + lane] = lane == 0 ? sq[t] : 0.f; }
    }
}

__device__ __forceinline__ void conv_phase(LAS unsigned char* lds, const bf16_t* U, bf16_t* C, const float* wdw, const float* bdw, const float* lng, const float* lnb,
                                           int first, int stride, int end, int tid, int wave, int lane) {
    constexpr int TT = 32, ROWS = TT + CW - 1;
    for (int tile = first; tile < end; tile += stride) {
        const int t0 = tile * TT, tin = t0 % SEQ;
        for (int idx = tid; idx < ROWS * 128; idx += NTHREADS) {
            const int row = idx >> 7, ch = idx & 127;
            u32x4 v = (u32x4){0u, 0u, 0u, 0u};
            if (tin + row - (CW - 1) >= 0) v = *(const u32x4*)(U + (size_t)(t0 + row - (CW - 1)) * D + ch * 8);
            *(LAS u32x4*)(lds + row * 2048 + ch * 16) = v;
        }
        asm volatile("s_waitcnt lgkmcnt(0)" ::: "memory"); __builtin_amdgcn_s_barrier(); asm volatile("" ::: "memory");
        typedef float f32x2 __attribute__((ext_vector_type(2)));
        f32x2 acc[2][4][4];
#pragma unroll
        for (int p = 0; p < 2; ++p) {
#pragma unroll
            for (int j = 0; j < 4; ++j)
#pragma unroll
                for (int c = 0; c < 4; ++c) acc[p][j][c] = (f32x2){0.f, 0.f};
            f32x4 wt[8][2];
            typedef const __attribute__((address_space(1))) f32x4 gf32x4;
            const gf32x4* wq = (const gf32x4*)(wdw + p * 512 + lane * 8);
#pragma unroll
            for (int t = 0; t < 4; ++t) { wt[t][0] = wq[0]; wt[t][1] = wq[1]; wq += D / 4; asm volatile("" : "+v"(wq)); }
#pragma unroll
            for (int r = 0; r < TT / NWAVES + CW - 1; ++r) {
                if (r + 4 < CW) { wt[(r + 4) & 7][0] = wq[0]; wt[(r + 4) & 7][1] = wq[1]; wq += D / 4; asm volatile("" : "+v"(wq)); }
                const u32x4 xv = *(const LAS u32x4*)(lds + (4 * wave + r) * 2048 + p * 1024 + lane * 16);
                f32x2 x[4];
#pragma unroll
                for (int i = 0; i < 4; ++i) x[i] = (f32x2){__uint_as_float(xv[i] << 16), __uint_as_float(xv[i] & 0xffff0000u)};
#pragma unroll
                for (int j = 0; j < 4; ++j) { const int w = r - j;
                    if (w >= 0 && w < CW) {
#pragma unroll
                        for (int c = 0; c < 4; ++c) { const f32x4 wv = wt[w & 7][c >> 1]; const f32x2 w2 = (c & 1) ? (f32x2){wv.z, wv.w} : (f32x2){wv.x, wv.y}; acc[p][j][c] = __builtin_elementwise_fma(w2, x[c], acc[p][j][c]); } } }
                asm volatile("" ::: "memory");
            }
            const f32x4 b0 = *(const f32x4*)(bdw + p * 512 + lane * 8), b1 = *(const f32x4*)(bdw + p * 512 + lane * 8 + 4);
#pragma unroll
            for (int j = 0; j < 4; ++j) { acc[p][j][0] += (f32x2){b0.x, b0.y}; acc[p][j][1] += (f32x2){b0.z, b0.w}; acc[p][j][2] += (f32x2){b1.x, b1.y}; acc[p][j][3] += (f32x2){b1.z, b1.w}; }
        }
        float mean[4], rstd[4];
#pragma unroll
        for (int j = 0; j < 4; ++j) { f32x2 s2 = (f32x2){0.f, 0.f};
#pragma unroll
            for (int p = 0; p < 2; ++p)
#pragma unroll
                for (int c = 0; c < 4; ++c) s2 += acc[p][j][c];
            mean[j] = wave_sum(s2.x + s2.y) * (1.f / D); f32x2 q2 = (f32x2){0.f, 0.f};
#pragma unroll
            for (int p = 0; p < 2; ++p)
#pragma unroll
                for (int c = 0; c < 4; ++c) { const f32x2 d = acc[p][j][c] - mean[j]; q2 += d * d; }
            rstd[j] = rsqrtf(wave_sum(q2.x + q2.y) * (1.f / D) + LN_EPS); }
#pragma unroll
        for (int p = 0; p < 2; ++p) {
            const f32x4 g0 = *(const f32x4*)(lng + p * 512 + lane * 8), g1 = *(const f32x4*)(lng + p * 512 + lane * 8 + 4);
            const f32x4 c0 = *(const f32x4*)(lnb + p * 512 + lane * 8), c1 = *(const f32x4*)(lnb + p * 512 + lane * 8 + 4);
            const f32x2 gg2[4] = {(f32x2){g0.x, g0.y}, (f32x2){g0.z, g0.w}, (f32x2){g1.x, g1.y}, (f32x2){g1.z, g1.w}}, bb2[4] = {(f32x2){c0.x, c0.y}, (f32x2){c0.z, c0.w}, (f32x2){c1.x, c1.y}, (f32x2){c1.z, c1.w}};
#pragma unroll
            for (int j = 0; j < 4; ++j) { unsigned wv[4];
#pragma unroll
                for (int c = 0; c < 4; ++c) {
                    const f32x2 y = __builtin_elementwise_fma(acc[p][j][c] - mean[j], gg2[c] * rstd[j], bb2[c]);
                    const f32x2 ne = y * (-LOG2E);
                    const f32x2 dd = (f32x2){__builtin_amdgcn_exp2f(ne.x), __builtin_amdgcn_exp2f(ne.y)} + 1.0f;
                    const f32x2 oo = y * (f32x2){__builtin_amdgcn_rcpf(dd.x), __builtin_amdgcn_rcpf(dd.y)};
                    wv[c] = cvt_pk_bf16(oo.x, oo.y); }
                u32x4 w; w.x = wv[0]; w.y = wv[1]; w.z = wv[2]; w.w = wv[3];
                *(u32x4*)(C + (size_t)(t0 + 4 * wave + j) * D + p * 512 + lane * 8) = w; }
        }
        asm volatile("s_waitcnt lgkmcnt(0)" ::: "memory"); __builtin_amdgcn_s_barrier(); asm volatile("" ::: "memory");
    }
}

__device__ __forceinline__ void attn_phase(LAS unsigned char* lds, const bf16_t* Q, const bf16_t* Kp, const bf16_t* Vp, bf16_t* O, int first, int stride, int end, int wave, int lane) {
    const int r32 = lane & 31, hi = lane >> 5;
    LAS unsigned char* vl = lds + wave * 8704;
    LAS unsigned char* kl = vl + 4096;
    const int trb = (4 * hi + ((lane & 15) >> 2)) * 128 + ((lane >> 4) & 1) * 32 + (lane & 3) * 8;
    for (int u = first + wave; u < end; u += stride) {
        const int bh = u >> 7, qblk = u & 127, b = bh >> 4, h = bh & 15;
        const size_t rowbase = (size_t)b * SEQ;
        const bf16_t* Qw = Q + (rowbase + qblk * 32 + r32) * D + h * HD + hi * 8;
        bf16x8 qr[4];
#pragma unroll
        for (int d0 = 0; d0 < 4; ++d0) qr[d0] = *(const bf16x8*)(Qw + d0 * 16);
        const bf16_t* Kl = Kp + (rowbase + (lane >> 3)) * D + h * HD + (lane & 7) * 8;
        const bf16_t* Vl = Vp + (rowbase + (lane >> 3)) * D + h * HD + (lane & 7) * 8;
        u32x4 kn[4]; u32x4 vn[4];
#pragma unroll
        for (int i = 0; i < 4; ++i) { kn[i] = *(const u32x4*)(Kl + (size_t)(qblk * 32 + 8 * i) * D); vn[i] = *(const u32x4*)(Vl + (size_t)(qblk * 32 + 8 * i) * D); }
        f32x16 o0 = {}, o1 = {}; float carry = 1.f;
        for (int kt = qblk; kt >= 0; --kt) {
#pragma unroll
            for (int i = 0; i < 4; ++i) { *(LAS u32x4*)(vl + ((lane >> 3) + 8 * i) * 128 + (lane & 7) * 16) = vn[i]; *(LAS u32x4*)(kl + ((lane >> 3) + 8 * i) * 144 + (lane & 7) * 16) = kn[i]; }
            bf16x8 kc[4];
#pragma unroll
            for (int i = 0; i < 4; ++i) kc[i] = *(const LAS bf16x8*)(kl + r32 * 144 + i * 32 + hi * 16);
            if (kt > 0) {
#pragma unroll
                for (int i = 0; i < 4; ++i) { kn[i] = *(const u32x4*)(Kl + (size_t)((kt - 1) * 32 + 8 * i) * D); vn[i] = *(const u32x4*)(Vl + (size_t)((kt - 1) * 32 + 8 * i) * D); }
            }
            f32x16 p = {};
#pragma unroll
            for (int d0 = 0; d0 < 4; ++d0) p = __builtin_amdgcn_mfma_f32_32x32x16_bf16(kc[d0], qr[d0], p, 0, 0, 0);
            const bool diag = (kt == qblk);
            float beta[16], om[16];
#pragma unroll
            for (int r = 0; r < 16; ++r) {
                const float z = p[r] * 0.125f, e = __builtin_amdgcn_exp2f(-LOG2E * __builtin_fabsf(z)), rc = __builtin_amdgcn_rcpf(1.f + e), sm = e * rc;
                const bool pos = z >= 0.f; float bt = pos ? rc : sm, o_ = pos ? sm : rc;
                const int kvl = (r & 3) + 8 * (r >> 2) + 4 * hi;
                if (diag && kvl >= r32) { bt = 0.f; o_ = 1.f; }
                beta[r] = bt; om[r] = o_;
            }
            float Gm[4], Gp[4];
#pragma unroll
            for (int g = 0; g < 4; ++g) { Gm[g] = (om[4 * g] * om[4 * g + 1]) * (om[4 * g + 2] * om[4 * g + 3]); Gp[g] = __shfl_xor(Gm[g], 32); }
            float SO[4], SP[4];
            SO[3] = 1.f; SO[2] = Gm[3]; SO[1] = SO[2] * Gm[2]; SO[0] = SO[1] * Gm[1];
            SP[3] = 1.f; SP[2] = Gp[3]; SP[1] = SP[2] * Gp[2]; SP[0] = SP[1] * Gp[1];
            float A[16];
#pragma unroll
            for (int g = 0; g < 4; ++g) {
                const float E = carry * SO[g] * (hi ? SP[g] : SP[g] * Gp[g]);
                const float P3 = E, P2 = P3 * om[4 * g + 3], P1 = P2 * om[4 * g + 2], P0 = P1 * om[4 * g + 1];
                A[4 * g + 3] = beta[4 * g + 3] * P3; A[4 * g + 2] = beta[4 * g + 2] * P2; A[4 * g + 1] = beta[4 * g + 1] * P1; A[4 * g] = beta[4 * g] * P0;
            }
            carry = carry * (SO[0] * Gm[0]) * (SP[0] * Gp[0]);
            u32x4 pw0, pw1;
            pw0.x = cvt_pk_bf16(A[0], A[1]); pw0.y = cvt_pk_bf16(A[2], A[3]); pw0.z = cvt_pk_bf16(A[4], A[5]); pw0.w = cvt_pk_bf16(A[6], A[7]);
            pw1.x = cvt_pk_bf16(A[8], A[9]); pw1.y = cvt_pk_bf16(A[10], A[11]); pw1.z = cvt_pk_bf16(A[12], A[13]); pw1.w = cvt_pk_bf16(A[14], A[15]);
            const bf16x8 pa0 = __builtin_bit_cast(bf16x8, pw0), pa1 = __builtin_bit_cast(bf16x8, pw1);
            asm volatile("s_waitcnt lgkmcnt(0)" ::: "memory");
#pragma unroll
            for (int s = 0; s < 2; ++s)
#pragma unroll
                for (int d0 = 0; d0 < 2; ++d0) {
                    const v4i16_t lo = __builtin_amdgcn_ds_read_tr16_b64_v4i16((LAS v4i16_t*)(vl + trb + s * 2048 + d0 * 64));
                    const v4i16_t hh = __builtin_amdgcn_ds_read_tr16_b64_v4i16((LAS v4i16_t*)(vl + trb + s * 2048 + 1024 + d0 * 64));
                    const bf16x8 vf = (bf16x8){lo[0], lo[1], lo[2], lo[3], hh[0], hh[1], hh[2], hh[3]};
                    if (d0 == 0) o0 = __builtin_amdgcn_mfma_f32_32x32x16_bf16(s ? pa1 : pa0, vf, o0, 0, 0, 0);
                    else         o1 = __builtin_amdgcn_mfma_f32_32x32x16_bf16(s ? pa1 : pa0, vf, o1, 0, 0, 0);
                }
            asm volatile("s_waitcnt lgkmcnt(0)" ::: "memory");
            if (__builtin_amdgcn_ballot_w64(carry > 5.4210109e-20f) == 0ull) break;
        }
        bf16_t* Ow = O + (rowbase + qblk * 32) * D + h * HD + r32;
#pragma unroll
        for (int r = 0; r < 16; ++r) { const int q = (r & 3) + 8 * (r >> 2) + 4 * hi;
            const unsigned w = cvt_pk_bf16(o0[r], o1[r]);
            Ow[(size_t)q * D] = (bf16_t)(w & 0xffffu); Ow[(size_t)q * D + 32] = (bf16_t)(w >> 16); }
    }
}

struct Args { const float* in[15]; float* out; unsigned char* ws; };

__global__ void __launch_bounds__(NTHREADS, 2) mk_fwd(Args a) {
    extern __shared__ __attribute__((aligned(16))) unsigned char lds_[];
    LAS unsigned char* lds = (LAS unsigned char*)lds_;
    cg::grid_group grid = cg::this_grid();
    int tid = threadIdx.x, lane = tid & 63, wave = __builtin_amdgcn_readfirstlane(tid >> 6);
    const int G = gridDim.x, bx = blockIdx.x, vcu = (G % 8 == 0) ? (bx % 8) * (G / 8) + bx / 8 : bx;
    Ptrs P;
    P.x = a.in[0]; P.norm_g = a.in[1]; P.final_g = a.in[2]; P.ffn_w_in = a.in[3]; P.ffn_w_out = a.in[4]; P.w_pw1 = a.in[5]; P.b_pw1 = a.in[6]; P.w_dw = a.in[7]; P.b_dw = a.in[8];
    P.ln_g = a.in[9]; P.ln_b = a.in[10]; P.w_pw2 = a.in[11]; P.b_pw2 = a.in[12]; P.w_qkv = a.in[13]; P.w_o = a.in[14]; P.out = a.out; P.ws = a.ws;
    float* ssp = (float*)(P.ws + WS_SSP);
    bf16_t* Win = (bf16_t*)(P.ws + WS_WIN); bf16_t* Wout = (bf16_t*)(P.ws + WS_WOUT);
    bf16_t* Wpw1 = (bf16_t*)(P.ws + WS_WPW1); bf16_t* Wpw2 = (bf16_t*)(P.ws + WS_WPW2); bf16_t* Wqkv = (bf16_t*)(P.ws + WS_WQKV); bf16_t* Wo = (bf16_t*)(P.ws + WS_WO);
    bf16_t* xb = (bf16_t*)(P.ws + WS_XB); bf16_t* R = (bf16_t*)(P.ws + WS_R); bf16_t* Ob = (bf16_t*)(P.ws + WS_O);

    prologue(P, lds, vcu, G, wave, lane);
    unsigned* barw = (unsigned*)(P.ws + WS_BAR);
    if (bx == 0) { for (int i = threadIdx.x; i < XB_ALL_WORDS; i += NTHREADS) __hip_atomic_store(barw + i, 0u, __ATOMIC_RELAXED, __HIP_MEMORY_SCOPE_AGENT); }
    volatile LAS unsigned* bst = (volatile LAS unsigned*)(lds + LDS_BYTES - 16);
    unsigned* slots = barw + XB_ALL_WORDS;
    XcdBarrier bar; bar.bar = barw; bar.x = xb_xcc_id(); bar.st = bst;
    volatile LAS unsigned* cen = (volatile LAS unsigned*)(lds + 1024);
    if (threadIdx.x < 4) bst[threadIdx.x] = 0u;
    if (threadIdx.x < 17) cen[threadIdx.x] = 0u;
    if (threadIdx.x == 0) __hip_atomic_store(slots + bx, bar.x, __ATOMIC_RELAXED, __HIP_MEMORY_SCOPE_AGENT);
    grid.sync();
    for (int t = threadIdx.x; t < G; t += NTHREADS) {
        const unsigned v = __hip_atomic_load(slots + t, __ATOMIC_RELAXED, __HIP_MEMORY_SCOPE_AGENT) & 15u;
        __hip_atomic_fetch_add((LAS unsigned*)(lds + 1024) + v, 1u, __ATOMIC_RELAXED, __HIP_MEMORY_SCOPE_WORKGROUP);
        if (v == bar.x && t < bx) __hip_atomic_fetch_add((LAS unsigned*)(lds + 1024) + 16, 1u, __ATOMIC_RELAXED, __HIP_MEMORY_SCOPE_WORKGROUP);
    }
    __syncthreads();
    if (threadIdx.x == 0) {
        unsigned ok = (G % 8 == 0) && (bar.x < 8u) ? 1u : 0u, nx = 0u;
        for (unsigned j = 0; j < 16; ++j) { const unsigned c = cen[j]; nx += c ? 1u : 0u; if (c != (j < 8u ? (unsigned)(G / 8) : 0u)) ok = 0u; }
        bst[0] = cen[bar.x]; bst[1] = nx ? nx : 1u;
        bst[2] = cen[16]; bst[3] = ok;
    }
    __syncthreads();
#pragma unroll 1
    for (int l = 0; l < 2; ++l) {
#pragma unroll 1
        for (int s = 0; s < 7; ++s) {
            tid = threadIdx.x; asm volatile("" : "+v"(tid)); lane = tid & 63; wave = __builtin_amdgcn_readfirstlane(tid >> 6);
            const bool local = bst[3] != 0u; const int xq = (int)bar.x, rank = (int)bst[2], nl = G / 8;
            const int vb = local ? xq + 8 * rank : bx;
            const size_t SLAB = (size_t)12 * 1024 * 1024, T8 = (size_t)4 * 1024 * 1024;
            bf16_t* Rx = local ? R + (size_t)xq * SLAB : R; const size_t ro = local ? (size_t)xq * SEQ : 0;
            bf16_t* act = Rx - ro * FF; bf16_t* ub = Rx - ro * D; bf16_t* cb = (local ? Rx + T8 : R + (size_t)M * D) - ro * D;
            bf16_t* qb = ub; bf16_t* kb = cb; bf16_t* vb_ = (local ? Rx + 2 * T8 : R + (size_t)2 * M * D) - ro * D;
            const size_t qkv_stride = local ? T8 : (size_t)M * D;
            if (s == 0 || s == 5) {
                const int j = s == 0 ? 0 : 1;
                pg8::Gemm g{xb, Win + (size_t)(l * 2 + j) * WIN_STRIDE, M, 2 * FF, D}; pg8::StaticOrder S; S.init(M, 2 * FF, G, vb);
                EpiSwiGLU E{act, ssp + (size_t)(3 * l + (j ? 2 : 0)) * SSP_STRIDE};
                pg8::gemm_phase<EpiSwiGLU, pg8::StaticOrder, true, true>(lds, g, S, E);
            } else if (s == 1 || s == 4 || s == 6) {
                const bf16_t* A; const bf16_t* W; int K; float alpha; const float* bias; int so;
                if (s == 4) { A = l == 0 ? cb : Ob; W = l == 0 ? Wpw2 : Wo; K = D; alpha = 1.f; bias = l == 0 ? P.b_pw2 : nullptr; so = 3 * l + 2; }
                else { const int j = s == 1 ? 0 : 1; A = act; W = Wout + (size_t)(l * 2 + j) * WOUT_STRIDE; K = FF; alpha = 0.5f; bias = nullptr; so = 3 * l + (j ? 3 : 1); }
                pg8::Gemm g{A, W, M, D, K}; pg8::StaticOrder S; S.init(M, D, G, vb);
                EpiResid E{xb, ssp + (size_t)so * SSP_STRIDE, bias, alpha};
                pg8::gemm_phase<EpiResid, pg8::StaticOrder, true, true>(lds, g, S, E);
            } else if (s == 2) {
                if (l == 0) {
                    pg8::Gemm g{xb, Wpw1, M, 2 * D, D}; pg8::StaticOrder S; S.init(M, 2 * D, G, vb);
                    EpiGLU E{ub, ssp + (size_t)1 * SSP_STRIDE, P.b_pw1};
                    pg8::gemm_phase<EpiGLU, pg8::StaticOrder, true, true>(lds, g, S, E);
                } else {
                    pg8::Gemm g{xb, Wqkv, M, 3 * D, D}; pg8::StaticOrder S; S.init(M, 3 * D, G, vb);
                    EpiQKV E{qb, ssp + (size_t)4 * SSP_STRIDE, qkv_stride};
                    pg8::gemm_phase<EpiQKV, pg8::StaticOrder, true, true>(lds, g, S, E);
                }
            } else {
                if (l == 0) conv_phase(lds, ub, cb, P.w_dw, P.b_dw, P.ln_g, P.ln_b, local ? 128 * xq + rank : vcu, local ? nl : G, local ? 128 * (xq + 1) : M / 32, tid, wave, lane);
                if (l == 1) attn_phase(lds, qb, kb, vb_, Ob, local ? xq * 2048 + rank * NWAVES : vcu * NWAVES, (local ? nl : G) * NWAVES, local ? (xq + 1) * 2048 : NB * NH * (SEQ / 32), wave, lane);
            }
            if (local) xcd_local_barrier(bar); else xcd_barrier(bar);
        }
    }
    {
        const float* ss6 = ssp + (size_t)6 * SSP_STRIDE;
        const bool local = bst[3] != 0u; const int xq = (int)bar.x, rank = (int)bst[2], nl = G / 8;
        const int fn_first = local ? xq * SEQ + rank * NWAVES : vcu * NWAVES, fn_stride = (local ? nl : G) * NWAVES, fn_end = local ? (xq + 1) * SEQ : M;
        f32x4 gv[2][2];
#pragma unroll
        for (int p = 0; p < 2; ++p) { gv[p][0] = *(const f32x4*)(P.final_g + p * 512 + lane * 8); gv[p][1] = *(const f32x4*)(P.final_g + p * 512 + lane * 8 + 4); }
        for (int m = fn_first + wave; m < fn_end; m += fn_stride) {
            const float rs = row_rstd(ss6, m);
#pragma unroll
            for (int p = 0; p < 2; ++p) {
                const u32x4 w = *(const u32x4*)(xb + (size_t)m * D + p * 512 + lane * 8);
                const f32x4 v0 = (f32x4){__uint_as_float(w.x << 16), __uint_as_float(w.x & 0xffff0000u), __uint_as_float(w.y << 16), __uint_as_float(w.y & 0xffff0000u)};
                const f32x4 v1 = (f32x4){__uint_as_float(w.z << 16), __uint_as_float(w.z & 0xffff0000u), __uint_as_float(w.w << 16), __uint_as_float(w.w & 0xffff0000u)};
                float* o = P.out + (size_t)m * D + p * 512 + lane * 8;
                __builtin_nontemporal_store(v0 * rs * gv[p][0], (f32x4*)o); __builtin_nontemporal_store(v1 * rs * gv[p][1], (f32x4*)(o + 4));
            }
        }
    }
}
}

extern "C" void kernel_launch(void* const* d_in, const int* in_sizes, int n_in, void* d_out, int out_size, void* d_ws, size_t ws_size, hipStream_t stream) {
    static int grid = 0;
    if (grid == 0) {
        if (n_in != 15 || in_sizes[0] != mk::M * mk::D || out_size != mk::M * mk::D || ws_size < mk::WS_END) {
            fprintf(stderr, "kernel_launch: unexpected shapes (n_in %d, in0 %d, out %d, ws %zu); nothing launched\n", n_in, n_in > 0 ? in_sizes[0] : -1, out_size, ws_size); grid = -1; return; }
        int dev = 0, cus = 0, per_cu = 0;
        if (hipGetDevice(&dev) != hipSuccess || hipDeviceGetAttribute(&cus, hipDeviceAttributeMultiprocessorCount, dev) != hipSuccess) { grid = -1; return; }
        if (hipFuncSetAttribute((const void*)mk::mk_fwd, hipFuncAttributeMaxDynamicSharedMemorySize, mk::LDS_BYTES) != hipSuccess) { fprintf(stderr, "kernel_launch: hipFuncSetAttribute failed\n"); grid = -1; return; }
        if (hipOccupancyMaxActiveBlocksPerMultiprocessor(&per_cu, (const void*)mk::mk_fwd, mk::NTHREADS, mk::LDS_BYTES) != hipSuccess || per_cu < 1) { fprintf(stderr, "kernel_launch: occupancy query says %d\n", per_cu); per_cu = 1; }
        (void)hipGetLastError();
        grid = cus * per_cu;
    }
    if (grid < 0) return;
    mk::Args a{};
    for (int i = 0; i < 15; ++i) a.in[i] = (const float*)d_in[i];
    a.out = (float*)d_out; a.ws = (unsigned char*)d_ws;
    void* args[] = {&a};
    hipError_t e = hipLaunchCooperativeKernel((const void*)mk::mk_fwd, dim3(grid), dim3(mk::NTHREADS), args, mk::LDS_BYTES, stream);
    if (e != hipSuccess) fprintf(stderr, "kernel_launch: cooperative launch failed: %s (grid %d)\n", hipGetErrorString(e), grid);
}
```
